# Optimizing an MI355X kernel written in HIP

```python
import jax, jax.numpy as jnp
from jax import lax
import numpy as np


D_MODEL = 1024
BATCH = 8
SEQ = 4096
DEPTH = 4

MIX_WIDTH = D_MODEL
ATT_WIDTH = MIX_WIDTH // 2
RWKV_WIDTH = MIX_WIDTH - ATT_WIDTH
ATT_HEAD_DIM = 64
N_ATT_HEADS = ATT_WIDTH // ATT_HEAD_DIM
RWKV_HEAD_DIM = 64
N_RWKV_HEADS = RWKV_WIDTH // RWKV_HEAD_DIM
DILATED_PATTERNS = ((128, 1), (512, 4), (2048, 16))
ATT_BLOCK = 128
DECAY_LORA = 64
AAA_LORA = 64
VRES_LORA = 32
GATE_LORA = 128
RWKV_SHIFT_BASE = 3 * RWKV_WIDTH + DECAY_LORA + AAA_LORA + GATE_LORA
D_IN_BASE = 3 * ATT_WIDTH + RWKV_SHIFT_BASE
D_FF = 128 * ((8 * D_MODEL // 3 + 127) // 128)
N_EXPERTS = 8
TOP_K = 2
D_FF_EXPERT = 7 * D_MODEL // 2
N_DENSE = (DEPTH + 1) // 2
N_MOE = DEPTH // 2
DEEPNORM_ALPHA = float((2 * DEPTH) ** 0.25)
DEEPNORM_BETA = float((8 * DEPTH) ** -0.25)
LN_EPS = 1e-5
GN_EPS = 64e-5

kernel_name = 'hybrid_dilated_attn_rwkv7_moe_deepnorm'


def layer_norm(x, g, b):
    xf = x.astype(jnp.float32)
    mu = jnp.mean(xf, axis=-1, keepdims=True)
    var = jnp.mean(jnp.square(xf - mu), axis=-1, keepdims=True)
    return ((xf - mu) * lax.rsqrt(var + LN_EPS) * g + b).astype(x.dtype)


def token_shift(p, mu):
    prev = jnp.pad(p, ((0, 0), (1, 0), (0, 0)))[:, :-1]
    return p + (prev - p) * mu


def dilated_branch(q, k, v, window, dilation):
    B, S, H, Dh = q.shape
    steps = window // dilation
    L = S // dilation
    nb = -(-L // ATT_BLOCK)
    Lp = nb * ATT_BLOCK

    def blocks(t):
        t = t.reshape(B, L, dilation, H, Dh)
        t = jnp.pad(t, ((0, 0), (0, Lp - L), (0, 0), (0, 0), (0, 0)))
        return t.reshape(B, nb, ATT_BLOCK, dilation, H, Dh)

    def with_prev(t):
        prev = jnp.pad(t, ((0, 0), (1, 0), (0, 0), (0, 0), (0, 0), (0, 0)))[:, :-1]
        return jnp.concatenate([prev, t], axis=2)

    qb = blocks(q)
    kc = with_prev(blocks(k))
    vc = with_prev(blocks(v))
    s = jnp.einsum('bnqchd,bnkchd->bnchqk', qb, kc, preferred_element_type=jnp.float32)
    blk = jnp.arange(nb)[:, None] * ATT_BLOCK
    qi = blk + jnp.arange(ATT_BLOCK)[None, :]
    ki = blk + jnp.arange(2 * ATT_BLOCK)[None, :] - ATT_BLOCK
    dist = qi[:, :, None] - ki[:, None, :]
    valid = (dist >= 0) & (dist <= steps) & (ki[:, None, :] >= 0)
    s = jnp.where(valid[None, :, None, None], s, -jnp.inf)
    m = jnp.max(s, axis=-1, keepdims=True)
    p = jnp.exp(s - m)
    den = jnp.sum(p, axis=-1, keepdims=True)
    o = jnp.einsum('bnchqk,bnkchd->bnqchd', p / den, vc.astype(jnp.float32))
    lse = jnp.transpose((m + jnp.log(den))[..., 0], (0, 1, 4, 2, 3))
    o = o.reshape(B, Lp, dilation, H, Dh)[:, :L].reshape(B, S, H, Dh)
    lse = lse.reshape(B, Lp, dilation, H)[:, :L].reshape(B, S, H)
    return o, lse


def dilated_attention(q, k, v):
    outs, lses = [], []
    for window, dilation in DILATED_PATTERNS:
        o, lse = dilated_branch(q, k, v, window, dilation)
        outs.append(o)
        lses.append(lse)
    wts = jax.nn.softmax(jnp.stack(lses), axis=0)
    return jnp.sum(jnp.stack(outs) * wts[..., None], axis=0)


def rwkv7_time_mix(cols, v_first, decay_up, decay_base, aaa_up, aaa_base, gate_up,
                   k_k, k_a, r_k, lnx_g, lnx_b, vres_up, vres_base):
    B, S, _ = cols.shape
    H, N = N_RWKV_HEADS, RWKV_HEAD_DIM
    cuts = np.cumsum([RWKV_WIDTH] * 3 + [DECAY_LORA, AAA_LORA, GATE_LORA])
    r, k, v, wd, ad, gd, vd = jnp.split(cols, cuts, axis=-1)
    w_log = -jax.nn.softplus(-(decay_base + jnp.tanh(wd) @ decay_up)) - 0.5
    decay = jnp.exp(-jnp.exp(w_log))
    a = jax.nn.sigmoid(aaa_base + ad @ aaa_up)
    g = jax.nn.sigmoid(gd) @ gate_up
    if v_first is None:
        v_first = v
    else:
        v = v + (v_first - v) * jax.nn.sigmoid(vres_base + vd @ vres_up)
    heads = lambda t: t.reshape(B, S, H, N)
    kk = heads(k * k_k)
    kk = kk / jnp.maximum(jnp.sqrt(jnp.sum(kk * kk, axis=-1, keepdims=True)), 1e-12)
    k = k * (1.0 + (a - 1.0) * k_a)
    r_h, k_h, v_h, w_h, a_h = heads(r), heads(k), heads(v), heads(decay), heads(a)
    tm = lambda t: jnp.moveaxis(t, 1, 0)

    def step(state, inp):
        r_t, w_t, k_t, v_t, kk_t, a_t = inp
        sa = jnp.einsum('bhvk,bhk->bhv', state, -kk_t)
        state = (state * w_t[:, :, None, :] + sa[..., None] * (kk_t * a_t)[:, :, None, :]
                 + v_t[..., None] * k_t[:, :, None, :])
        return state, jnp.einsum('bhvk,bhk->bhv', state, r_t)

    state0 = jnp.zeros((B, H, N, N), jnp.float32)
    _, y = lax.scan(step, state0, (tm(r_h), tm(w_h), tm(k_h), tm(v_h), tm(kk), tm(a_h)))
    y = jnp.moveaxis(y, 0, 1)
    mu = jnp.mean(y, axis=-1, keepdims=True)
    var = jnp.mean(jnp.square(y - mu), axis=-1, keepdims=True)
    y = ((y - mu) * lax.rsqrt(var + GN_EPS)).reshape(B, S, RWKV_WIDTH) * lnx_g + lnx_b
    bonus = jnp.sum(r_h * k_h * r_k.reshape(H, N), axis=-1, keepdims=True) * v_h
    y = (y + bonus.reshape(B, S, RWKV_WIDTH)) * g
    return y, v_first


def hybrid_mixer(h, w_in_l, mu_l, w_out_l, v_first, decay_up, decay_base, aaa_up, aaa_base,
                 gate_up, k_k, k_a, r_k, lnx_g, lnx_b, vres_up, vres_base):
    B, S, _ = h.shape
    proj = h @ w_in_l
    q, k, v = jnp.split(proj[..., :3 * ATT_WIDTH], 3, axis=-1)
    ah = lambda t: t.reshape(B, S, N_ATT_HEADS, ATT_HEAD_DIM)
    att = dilated_attention(ah(q) * (ATT_HEAD_DIM ** -0.5), ah(k), ah(v)).reshape(B, S, ATT_WIDTH)
    cols = token_shift(proj[..., 3 * ATT_WIDTH:], mu_l).astype(jnp.float32)
    rw, v_first = rwkv7_time_mix(cols, v_first, decay_up, decay_base, aaa_up, aaa_base, gate_up,
                                 k_k, k_a, r_k, lnx_g, lnx_b, vres_up, vres_base)
    out = jnp.concatenate([att, rw], axis=-1).astype(h.dtype) @ w_out_l
    return out, v_first


def swiglu(h, wg, wu, wd):
    return (jax.nn.silu(h @ wg) * (h @ wu)) @ wd


def moe_swiglu(h, router_l, wg, wu, wd):
    logits = (h @ router_l).astype(jnp.float32)
    vals, idx = lax.top_k(logits, TOP_K)
    gates = jax.nn.softmax(vals, axis=-1)
    comb = jnp.sum(jax.nn.one_hot(idx, N_EXPERTS, dtype=jnp.float32) * gates[..., None], axis=-2)
    y = jnp.zeros(h.shape, jnp.float32)
    for e in range(N_EXPERTS):
        y = y + comb[..., e:e + 1] * swiglu(h, wg[e], wu[e], wd[e])
    return y.astype(h.dtype)


def setup_inputs(seed: int = 0) -> dict:
    key = jax.random.key(seed)
    ks = iter(jax.random.split(key, 40))
    nrm = lambda shape, scale: jax.random.normal(next(ks), shape, jnp.float32) * scale
    uni = lambda shape, lo, hi: jax.random.uniform(next(ks), shape, jnp.float32, lo, hi)
    L, D, W = DEPTH, D_MODEL, RWKV_WIDTH
    return {
        'x': nrm((BATCH, SEQ, D), 1.0),
        'w_in': nrm((L, D, D_IN_BASE), D ** -0.5),
        'w_in_vres': nrm((L - 1, D, VRES_LORA), D ** -0.5),
        'shift_mu': uni((L, RWKV_SHIFT_BASE), 0.0, 1.0),
        'shift_mu_vres': uni((L - 1, VRES_LORA), 0.0, 1.0),
        'decay_up': nrm((L, DECAY_LORA, W), 0.5 * DECAY_LORA ** -0.5),
        'decay_base': uni((L, W), -4.0, 1.0),
        'aaa_up': nrm((L, AAA_LORA, W), 0.5 * AAA_LORA ** -0.5),
        'aaa_base': nrm((L, W), 0.5),
        'vres_up': nrm((L - 1, VRES_LORA, W), 0.5 * VRES_LORA ** -0.5),
        'vres_base': nrm((L - 1, W), 0.5),
        'gate_up': nrm((L, GATE_LORA, W), GATE_LORA ** -0.5),
        'k_k': 0.85 + nrm((L, W), 0.05),
        'k_a': 1.0 + nrm((L, W), 0.05),
        'r_k': nrm((L, W), 0.1),
        'lnx_g': 1.0 + nrm((L, W), 0.05),
        'lnx_b': nrm((L, W), 0.02),
        'w_out': nrm((L, MIX_WIDTH, D), DEEPNORM_BETA * MIX_WIDTH ** -0.5),
        'ln1_g': 1.0 + nrm((L, D), 0.05),
        'ln1_b': nrm((L, D), 0.02),
        'ln2_g': 1.0 + nrm((L, D), 0.05),
        'ln2_b': nrm((L, D), 0.02),
        'ffn_w_gate': nrm((N_DENSE, D, D_FF), D ** -0.5),
        'ffn_w_up': nrm((N_DENSE, D, D_FF), D ** -0.5),
        'ffn_w_down': nrm((N_DENSE, D_FF, D), DEEPNORM_BETA * D_FF ** -0.5),
        'router': nrm((N_MOE, D, N_EXPERTS), D ** -0.5),
        'moe_w_gate': nrm((N_MOE, N_EXPERTS, D, D_FF_EXPERT), D ** -0.5),
        'moe_w_up': nrm((N_MOE, N_EXPERTS, D, D_FF_EXPERT), D ** -0.5),
        'moe_w_down': nrm((N_MOE, N_EXPERTS, D_FF_EXPERT, D), DEEPNORM_BETA * D_FF_EXPERT ** -0.5),
    }


def reference(x, w_in, w_in_vres, shift_mu, shift_mu_vres, decay_up, decay_base, aaa_up,
              aaa_base, vres_up, vres_base, gate_up, k_k, k_a, r_k, lnx_g, lnx_b, w_out,
              ln1_g, ln1_b, ln2_g, ln2_b, ffn_w_gate, ffn_w_up, ffn_w_down, router,
              moe_w_gate, moe_w_up, moe_w_down):
    v_first = None
    for l in range(DEPTH):
        if l == 0:
            w_in_l, mu_l, vu, vb = w_in[0], shift_mu[0], None, None
        else:
            w_in_l = jnp.concatenate([w_in[l], w_in_vres[l - 1]], axis=1)
            mu_l = jnp.concatenate([shift_mu[l], shift_mu_vres[l - 1]], axis=0)
            vu, vb = vres_up[l - 1], vres_base[l - 1]
        mix, v_first = hybrid_mixer(x, w_in_l, mu_l, w_out[l], v_first, decay_up[l], decay_base[l],
                                    aaa_up[l], aaa_base[l], gate_up[l], k_k[l], k_a[l], r_k[l],
                                    lnx_g[l], lnx_b[l], vu, vb)
        x = layer_norm(DEEPNORM_ALPHA * x + mix, ln1_g[l], ln1_b[l])
        if l % 2 == 0:
            i = l // 2
            f = swiglu(x, ffn_w_gate[i], ffn_w_up[i], ffn_w_down[i])
        else:
            i = l // 2
            f = moe_swiglu(x, router[i], moe_w_gate[i], moe_w_up[i], moe_w_down[i])
        x = layer_norm(DEEPNORM_ALPHA * x + f, ln2_g[l], ln2_b[l])
    return x
```

```cpp
#include <hip/hip_runtime.h>
#include <cstdio>
#include <cstdint>
#include <cmath>
namespace pg8 {
#define PG8_LAS __attribute__((address_space(3)))
typedef unsigned short bf16_t;
typedef short bf16x8 __attribute__((ext_vector_type(8)));
typedef float f32x4 __attribute__((ext_vector_type(4)));
typedef unsigned u32x4 __attribute__((ext_vector_type(4)));
constexpr int BM = 256, BK = 64, HALF = 128, HTB = HALF * BK * 2  , STAGE_BYTES = 8 * HTB, NXCD = 8, WGM = 8;

__host__ __device__ __forceinline__ int lds_byte(int r, int c) { const int st = (r >> 4) * 2 + (c >> 5), rr = r & 15, cc = c & 31, ob = rr * 64 + cc * 2; return st * 1024 + (ob ^ (((ob >> 9) & 1) << 5)); }
__host__ __device__ __forceinline__ void stage_rc(int b, int& R, int& C) { const int st = b / 1024, sb = b % 1024, swz = sb ^ (((sb >> 9) & 1) << 5); R = (st >> 1) * 16 + swz / 64; C = (st & 1) * 32 + (swz % 64) / 2; }
__host__ __device__ __forceinline__ int perm32(int rho) { const int n = rho >> 4, i = rho & 15; return 8 * (i >> 2) + 4 * n + (i & 3); }

struct Unit { int pm, pn; unsigned bofs; };
struct Gemm { const bf16_t* A; const bf16_t* Bt; int M, N, K; };

struct StaticOrder {
    int nM, nN, nwg, G, c;
    __host__ __device__ void init(int M, int N, int G_, int c_) { nM = M / BM; nN = N / BM; nwg = nM * nN; G = G_; c = c_; }
    __host__ __device__ bool next(int i, Unit& u) const {
        const long L = (long)i * G + c; if (L >= nwg) return false;
        int wgid = (int)L; { const int q = nwg / NXCD, r = nwg % NXCD, xcd = wgid % NXCD, off = wgid / NXCD; wgid = (xcd < r ? xcd * (q + 1) : r * (q + 1) + (xcd - r) * q) + off; }
        const int nig = WGM * nN, gid = wgid / nig, fm = gid * WGM, gsz = (nM - fm) < WGM ? (nM - fm) : WGM;
        u.pm = fm + ((wgid % nig) % gsz); u.pn = (wgid % nig) / gsz; u.bofs = 0u; return true;
    }
    __device__ __forceinline__ void a_ready(const Unit&) const {}
    __device__ __forceinline__ void done(const Unit&) const {}
};

__device__ __forceinline__ unsigned cvt_pk_bf16(float lo, float hi) { unsigned r; asm volatile("v_cvt_pk_bf16_f32 %0, %1, %2" : "=v"(r) : "v"(lo), "v"(hi)); return r; }
typedef float f32x2 __attribute__((ext_vector_type(2)));
__device__ __forceinline__ f32x2 gelu_pk(f32x2 v) {
    const f32x2 av = __builtin_elementwise_abs(v), d = av * 0.2316418882f + 1.0f;
    f32x2 t; t.x = __builtin_amdgcn_rcpf(d.x); t.y = __builtin_amdgcn_rcpf(d.y);
    f32x2 q = t * 0.5307027145f + (-0.7265760135f); q = q * t + 0.7107068705f; q = q * t + (-0.142248368f); q = q * t + 0.127414796f; q = q * t;
    const f32x2 s = (v * v) * (-0.72134752044f);
    f32x2 e; e.x = __builtin_amdgcn_exp2f(s.x); e.y = __builtin_amdgcn_exp2f(s.y);
    const f32x2 m = v * (q * e), r = v - m;
    f32x2 o; o.x = v.x < 0.f ? m.x : r.x; o.y = v.y < 0.f ? m.y : r.y; return o;
}

template <int ACT  > struct EpiBf16 {
    static constexpr bool PERM = true, AFTER_DRAIN = false; static_assert(ACT == 0 || ACT == 1, "EpiBf16: ACT is 0 (none) or 1 (gelu_pk)");
    bf16_t* O; int ldc; const float* bias; int split_cols; size_t split_stride; float scale0;
    __device__ __forceinline__ void operator()(const f32x4 (&acc)[2][2][4][2], const Unit& u, int wr, int wc, int fr, int fq) const {
        const int row0 = u.pm * BM + wr * 64 + fr; int colt = u.pn * BM; bf16_t* base = O;
        float sc = 1.f; if (split_cols) { const int t = colt / split_cols; base += (size_t)t * split_stride; colt -= t * split_cols; if (t == 0) sc = scale0; }
        const int col0 = colt + wc * 32 + 8 * fq, bcol0 = u.pn * BM + wc * 32 + 8 * fq;
        f32x4 bv[2][2];
#pragma unroll
        for (int bj = 0; bj < 2; ++bj)
#pragma unroll
            for (int n = 0; n < 2; ++n) bv[bj][n] = bias ? *(const f32x4*)(bias + bcol0 + bj * HALF + 4 * n) : (f32x4){0.f, 0.f, 0.f, 0.f};
#pragma unroll
        for (int ai = 0; ai < 2; ++ai)
#pragma unroll
            for (int m = 0; m < 4; ++m) { bf16_t* rowp = base + (size_t)(row0 + ai * HALF + m * 16) * ldc + col0;
#pragma unroll
                for (int bj = 0; bj < 2; ++bj) { f32x4 v0 = acc[ai][bj][m][0] + bv[bj][0], v1 = acc[ai][bj][m][1] + bv[bj][1];
                    if (ACT == 1) { f32x2 a = gelu_pk((f32x2){v0[0], v0[1]}), b = gelu_pk((f32x2){v0[2], v0[3]}), c = gelu_pk((f32x2){v1[0], v1[1]}), d = gelu_pk((f32x2){v1[2], v1[3]});
                        v0 = (f32x4){a.x, a.y, b.x, b.y}; v1 = (f32x4){c.x, c.y, d.x, d.y}; }
                    v0 = v0 * sc; v1 = v1 * sc; u32x4 w; w.x = cvt_pk_bf16(v0[0], v0[1]); w.y = cvt_pk_bf16(v0[2], v0[3]); w.z = cvt_pk_bf16(v1[0], v1[1]); w.w = cvt_pk_bf16(v1[2], v1[3]);
                    *(u32x4*)(rowp + bj * HALF) = w; } }
    }
};

template <class Epi, class Sched, bool ALIGN_EPI = false, bool SP2 = false>
__device__ __forceinline__ void gemm_phase(PG8_LAS unsigned char* lds, const Gemm g, const Sched& S, const Epi& E) {
    int tid_l = threadIdx.x; asm volatile("" : "+v"(tid_l));
    const int tid = tid_l, wid = __builtin_amdgcn_readfirstlane(tid >> 6), lane = tid & 63, wr = wid >> 2, wc = wid & 3, fr = lane & 15, fq = lane >> 4;
    const int K = g.K, nt = K / BK;
    unsigned voffA[2], voffB[2];
#pragma unroll
    for (int i = 0; i < 2; ++i) { int R, C; stage_rc(tid * 16 + i * 8192, R, C); const int Rb = Epi::PERM ? ((R & ~31) + perm32(R & 31)) : R;
        voffA[i] = (unsigned)(R * K + C) * 2u; voffB[i] = (unsigned)(Rb * K + C) * 2u; }
    const size_t kstep = (size_t)(BK * 2);
    const size_t hstep = (size_t)HALF * K * 2;
    const size_t tstep = 2 * hstep;
    const unsigned ldsw = (unsigned)wid * 1024u;
    const int aoff = lds_byte(wr * 64 + fr, fq * 8), boff = lds_byte(wc * 32 + fr, fq * 8);
#define PG8_SA(b, h) (((b) * 2 + (h)) * HTB)
#define PG8_SB(b, h) ((4 + (b) * 2 + (h)) * HTB)
#define PG8_STAGE(bufoff, gbase, voff) do { _Pragma("unroll") for (int _i = 0; _i < 2; ++_i) \
        __builtin_amdgcn_global_load_lds((const unsigned*)((const char*)(gbase) + (voff)[_i]), (PG8_LAS unsigned*)(lds + (bufoff) + ldsw + _i * 8192), 16, 0, 0); } while (0)
#define PG8_LDA(dst, b, h) do { _Pragma("unroll") for (int m = 0; m < 4; ++m) _Pragma("unroll") for (int k = 0; k < 2; ++k) dst[m][k] = *(const PG8_LAS bf16x8*)(lds + PG8_SA(b, h) + aoff + m * 2048 + k * 1024); } while (0)
#define PG8_LDB(dst, b, h) do { _Pragma("unroll") for (int n = 0; n < 2; ++n) _Pragma("unroll") for (int k = 0; k < 2; ++k) dst[n][k] = *(const PG8_LAS bf16x8*)(lds + PG8_SB(b, h) + boff + n * 2048 + k * 1024); } while (0)
#define PG8_MMA(ai, bj, At, Bt) do { __builtin_amdgcn_s_setprio(1); _Pragma("unroll") for (int m = 0; m < 4; ++m) _Pragma("unroll") for (int n = 0; n < 2; ++n) _Pragma("unroll") for (int k = 0; k < 2; ++k) \
        acc[ai][bj][m][n] = __builtin_amdgcn_mfma_f32_16x16x32_bf16(Bt[n][k], At[m][k], acc[ai][bj][m][n], 0, 0, 0); __builtin_amdgcn_s_setprio(0); } while (0)
#define PG8_WAIT_V(n) asm volatile("s_waitcnt vmcnt(" #n ")" ::: "memory")
#define PG8_WAIT_L(n) asm volatile("s_waitcnt lgkmcnt(" #n ")" ::: "memory")
#define PG8_BAR __builtin_amdgcn_s_barrier()
#define PG8_SCHED __builtin_amdgcn_sched_barrier(0)
    Unit cur, nxt; int ui = 0;
    if (!S.next(0, cur)) return;
    f32x4 acc[2][2][4][2];
#pragma unroll
    for (int a = 0; a < 2; ++a)
#pragma unroll
        for (int b = 0; b < 2; ++b)
#pragma unroll
            for (int m = 0; m < 4; ++m)
#pragma unroll
                for (int n = 0; n < 2; ++n) acc[a][b][m][n] = (f32x4){0.f, 0.f, 0.f, 0.f};
    bf16x8 At[4][2], B0[2][2], B1[2][2];
    const char* cA = (const char*)g.A + (size_t)cur.pm * tstep; const char* cB = (const char*)g.Bt + (size_t)cur.bofs + (size_t)cur.pn * tstep;
    S.a_ready(cur);
    if constexpr (SP2) {
        PG8_STAGE(PG8_SB(0, 0), cB, voffB); PG8_STAGE(PG8_SB(0, 1), cB + hstep, voffB); PG8_STAGE(PG8_SA(0, 0), cA, voffA); PG8_STAGE(PG8_SA(0, 1), cA + hstep, voffA);
        if (wr == 1) PG8_BAR;
        PG8_WAIT_V(2); PG8_BAR;
        PG8_STAGE(PG8_SB(1, 0), cB + kstep, voffB); PG8_STAGE(PG8_SA(1, 0), cA + kstep, voffA); PG8_STAGE(PG8_SB(1, 1), cB + hstep + kstep, voffB);
        PG8_WAIT_V(6); PG8_BAR;
    } else {
        PG8_STAGE(PG8_SB(0, 0), cB, voffB); PG8_STAGE(PG8_SA(0, 0), cA, voffA); PG8_STAGE(PG8_SB(0, 1), cB + hstep, voffB); PG8_STAGE(PG8_SA(0, 1), cA + hstep, voffA);
        if (wr == 1) PG8_BAR;
        PG8_WAIT_V(4); PG8_BAR;
        PG8_STAGE(PG8_SB(1, 0), cB + kstep, voffB); PG8_STAGE(PG8_SA(1, 0), cA + kstep, voffA); PG8_STAGE(PG8_SB(1, 1), cB + hstep + kstep, voffB);
        PG8_WAIT_V(6); PG8_BAR;
    }
    for (;;) {
        const bool has_next = S.next(ui + 1, nxt);
        const char* nA = has_next ? (const char*)g.A + (size_t)nxt.pm * tstep : cA; const char* nB = has_next ? (const char*)g.Bt + (size_t)nxt.bofs + (size_t)nxt.pn * tstep : cB;
        for (int t = 0; t < nt; t += 2) {
            const bool last = (t == nt - 2);
            const char* a1 = cA + (size_t)(t + 1) * kstep;
            const char* a2 = last ? nA : cA + (size_t)(t + 2) * kstep; const char* b2 = last ? nB : cB + (size_t)(t + 2) * kstep;
            const char* a3 = a2 + kstep; const char* b3 = b2 + kstep;
            if (last && has_next) S.a_ready(nxt);
            if constexpr (SP2) {
            PG8_LDB(B0, 0, 0); PG8_LDB(B1, 0, 1); PG8_SCHED; PG8_LDA(At, 0, 0); PG8_STAGE(PG8_SA(1, 1), a1 + hstep, voffA);
            PG8_WAIT_V(8); PG8_WAIT_L(0); PG8_BAR; PG8_MMA(0, 0, At, B0); PG8_MMA(0, 1, At, B1); PG8_BAR; PG8_SCHED;
            PG8_LDA(At, 0, 1); PG8_STAGE(PG8_SB(0, 0), b2, voffB); PG8_STAGE(PG8_SB(0, 1), b2 + hstep, voffB); PG8_STAGE(PG8_SA(0, 0), a2, voffA);
            PG8_WAIT_V(8); PG8_WAIT_L(0); PG8_BAR; PG8_MMA(1, 0, At, B0); PG8_MMA(1, 1, At, B1); PG8_BAR; PG8_SCHED;
            PG8_LDB(B0, 1, 0); PG8_LDB(B1, 1, 1); PG8_SCHED; PG8_LDA(At, 1, 0); PG8_STAGE(PG8_SA(0, 1), a2 + hstep, voffA);
            PG8_WAIT_V(8); PG8_WAIT_L(0); PG8_BAR; PG8_MMA(0, 0, At, B0); PG8_MMA(0, 1, At, B1); PG8_BAR; PG8_SCHED;
            PG8_LDA(At, 1, 1); PG8_STAGE(PG8_SB(1, 0), b3, voffB); PG8_STAGE(PG8_SB(1, 1), b3 + hstep, voffB); PG8_STAGE(PG8_SA(1, 0), a3, voffA);
            PG8_WAIT_V(8); PG8_WAIT_L(0); PG8_BAR; PG8_MMA(1, 0, At, B0); PG8_MMA(1, 1, At, B1); PG8_BAR; PG8_SCHED;
            } else {
            PG8_LDB(B0, 0, 0); PG8_SCHED; PG8_LDA(At, 0, 0); PG8_STAGE(PG8_SA(1, 1), a1 + hstep, voffA);
            PG8_WAIT_L(8); PG8_BAR; PG8_WAIT_L(0); PG8_MMA(0, 0, At, B0); PG8_BAR; PG8_SCHED;
            PG8_LDB(B1, 0, 1); PG8_STAGE(PG8_SB(0, 0), b2, voffB);
            PG8_BAR; PG8_WAIT_L(0); PG8_MMA(0, 1, At, B1); PG8_BAR;
            PG8_LDA(At, 0, 1); PG8_STAGE(PG8_SA(0, 0), a2, voffA);
            PG8_BAR; PG8_WAIT_L(0); PG8_MMA(1, 0, At, B0); PG8_BAR; PG8_SCHED;
            PG8_STAGE(PG8_SB(0, 1), b2 + hstep, voffB);
            PG8_WAIT_V(6); PG8_BAR; PG8_MMA(1, 1, At, B1); PG8_BAR;
            PG8_LDB(B0, 1, 0); PG8_SCHED; PG8_LDA(At, 1, 0); PG8_STAGE(PG8_SA(0, 1), a2 + hstep, voffA);
            PG8_WAIT_L(8); PG8_BAR; PG8_WAIT_L(0); PG8_MMA(0, 0, At, B0); PG8_BAR; PG8_SCHED;
            PG8_LDB(B1, 1, 1); PG8_STAGE(PG8_SB(1, 0), b3, voffB);
            PG8_BAR; PG8_WAIT_L(0); PG8_MMA(0, 1, At, B1); PG8_BAR;
            PG8_LDA(At, 1, 1); PG8_STAGE(PG8_SA(1, 0), a3, voffA);
            PG8_BAR; PG8_WAIT_L(0); PG8_MMA(1, 0, At, B0); PG8_BAR; PG8_SCHED;
            PG8_STAGE(PG8_SB(1, 1), b3 + hstep, voffB);
            PG8_WAIT_V(6); PG8_BAR; PG8_MMA(1, 1, At, B1); PG8_BAR;
            }
        }
        if constexpr (ALIGN_EPI) { if (wr == 0) PG8_BAR; }
        if constexpr (!Epi::AFTER_DRAIN) { E(acc, cur, wr, wc, fr, fq); S.done(cur); }
        if (!has_next) break;
#pragma unroll
        for (int a = 0; a < 2; ++a)
#pragma unroll
            for (int b = 0; b < 2; ++b)
#pragma unroll
                for (int m = 0; m < 4; ++m)
#pragma unroll
                    for (int n = 0; n < 2; ++n) acc[a][b][m][n] = (f32x4){0.f, 0.f, 0.f, 0.f};
        cur = nxt; cA = nA; cB = nB; ++ui;
        if constexpr (ALIGN_EPI) { if (wr == 1) PG8_BAR; }
    }
    PG8_WAIT_V(0);
    if constexpr (!ALIGN_EPI) { if (wr == 0) PG8_BAR; }
    PG8_BAR;
    if constexpr (Epi::AFTER_DRAIN) { E.fused(acc, cur, wr, wc, fr, fq, lds, wid, lane); S.done(cur); }
#undef PG8_SA
#undef PG8_SB
#undef PG8_STAGE
#undef PG8_LDA
#undef PG8_LDB
#undef PG8_MMA
#undef PG8_WAIT_V
#undef PG8_WAIT_L
#undef PG8_BAR
#undef PG8_SCHED
}
}
#define GAS __attribute__((address_space(1)))
#define LAS __attribute__((address_space(3)))
typedef unsigned short bf16;
typedef unsigned v4u __attribute__((ext_vector_type(4)));
typedef float f32x4 __attribute__((ext_vector_type(4)));
typedef short bf16x8 __attribute__((ext_vector_type(8)));
typedef GAS unsigned gu32;
typedef GAS unsigned long long gu64;
#define RLX_AGENT __ATOMIC_RELAXED, __HIP_MEMORY_SCOPE_AGENT
#define LDS_WAIT() asm volatile("s_waitcnt lgkmcnt(0)" ::: "memory")
#define VM_WAIT() asm volatile("s_waitcnt vmcnt(0)" ::: "memory")
__device__ __forceinline__ unsigned long long rt() { return __builtin_amdgcn_s_memrealtime(); }
__device__ __forceinline__ unsigned f2bf(float f) { unsigned u = __builtin_bit_cast(unsigned, f); return (u + 0x7fffu + ((u >> 16) & 1u)) >> 16; }
__device__ __forceinline__ unsigned pk2(float lo, float hi) { return f2bf(lo) | (f2bf(hi) << 16); }

#define XB_TMO      128
#define XB_XCNT(j)  (256  + 64 * (j))
#define XB_XSUB(j)  (1280 + 64 * (j))
#define XB_XGEN(j)  (2304 + 64 * (j))
#define XB_TOP      3328
#define XB_TOPGEN   3392
#define XCD_BAR_WORDS 3456
#define XB_SPIN_CAP (1u << 18)

__device__ __forceinline__ unsigned xb_ld(unsigned* p)              { return __hip_atomic_load(p, __ATOMIC_RELAXED, __HIP_MEMORY_SCOPE_AGENT); }
__device__ __forceinline__ unsigned xb_add(unsigned* p, unsigned v) { return __hip_atomic_fetch_add(p, v, __ATOMIC_RELAXED, __HIP_MEMORY_SCOPE_AGENT); }
__device__ __forceinline__ unsigned xb_xcc_id() { return (unsigned)__builtin_amdgcn_s_getreg((3 << 11) | 20) & 0xFu; }
#define XB_SPIN(cond, bar) do { unsigned _sp = 0; while (cond) { __builtin_amdgcn_s_sleep(1); \
    if ((++_sp & 255u) == 0u) { if (xb_ld(&(bar)[XB_TMO])) break; if (_sp > XB_SPIN_CAP) { atomicAdd(&(bar)[XB_TMO], 1u); break; } } } } while (0)

struct XcdBarrier {
    unsigned* bar; unsigned x;
    volatile LAS unsigned* st;
};

__device__ __forceinline__ XcdBarrier xcd_barrier_post(unsigned* bar, volatile LAS unsigned* st) {
    XcdBarrier b; b.bar = bar; b.x = xb_xcc_id(); b.st = st;
    if (threadIdx.x == 0) (void)xb_add(&bar[XB_XCNT(b.x)], 1u);
    return b;
}
__device__ __forceinline__ void xcd_barrier_complete(unsigned* bar, unsigned x, unsigned& nloc, unsigned& nx) {
    const unsigned G = gridDim.x * gridDim.y * gridDim.z;
    unsigned sum, cnt, mine, sp = 0u;
    for (;;) {
        sum = 0u; cnt = 0u; mine = 0u;
#pragma unroll
        for (unsigned j = 0; j < 16; ++j) { const unsigned c = xb_ld(&bar[XB_XCNT(j)]); sum += c; cnt += (c > 0u) ? 1u : 0u; mine = (j == x) ? c : mine; }
        if (sum == G) break;
        __builtin_amdgcn_s_sleep(1);
        if ((++sp & 255u) == 0u) { if (xb_ld(&bar[XB_TMO])) break; if (sp > XB_SPIN_CAP) { atomicAdd(&bar[XB_TMO], 1u); break; } }
    }
    nloc = mine > 0u ? mine : 1u; nx = cnt > 0u ? cnt : 1u;
}

__device__ __forceinline__ void xcd_barrier(const XcdBarrier& b) {
    asm volatile("s_waitcnt vmcnt(0)" ::: "memory");
    __syncthreads();
    if (threadIdx.x == 0) {
        unsigned* bar = b.bar;
        __builtin_amdgcn_s_waitcnt(0);
        unsigned nloc = b.st[0], nx = b.st[1];
        if (nloc == 0u) { xcd_barrier_complete(bar, b.x, nloc, nx); b.st[0] = nloc; b.st[1] = nx; }
        const unsigned old = xb_add(&bar[XB_XSUB(b.x)], 1u);
        const unsigned gen = old / nloc;
        if (old + 1u == (gen + 1u) * nloc) {
            __builtin_amdgcn_fence(__ATOMIC_RELEASE, "agent");
            asm volatile("s_waitcnt vmcnt(0)" ::: "memory");
            const unsigned og = xb_add(&bar[XB_TOP], 1u);
            const unsigned tg = og / nx;
            if (og + 1u == (tg + 1u) * nx) xb_add(&bar[XB_TOPGEN], 1u);
            else XB_SPIN(xb_ld(&bar[XB_TOPGEN]) == tg, bar);
            __builtin_amdgcn_fence(__ATOMIC_ACQUIRE, "agent");
            xb_add(&bar[XB_XGEN(b.x)], 1u);
            asm volatile("s_waitcnt vmcnt(0)" ::: "memory");
        } else {
            XB_SPIN(xb_ld(&bar[XB_XGEN(b.x)]) == gen, bar);
            __builtin_amdgcn_fence(__ATOMIC_ACQUIRE, "agent");
            asm volatile("s_waitcnt vmcnt(0)" ::: "memory");
        }
    }
    __syncthreads();
}

constexpr int NWAVES = 8;
constexpr int BATCH = 8, SEQ = 4096, M = BATCH * SEQ, D = 1024, DEPTH = 4;
constexpr int NPROJ = 3584;
constexpr int HW = 512;
constexpr int DFF = 2816, DFE = 3584, NEXP = 8;
constexpr int MOE_ROWS = 2 * M + NEXP * 256;
constexpr float DN_ALPHA = 1.681792830507429f;
constexpr float LN_EPS = 1e-5f, GN_EPS = 64e-5f;
constexpr int PH_PER_LAYER = 12, N_PHASES = DEPTH * PH_PER_LAYER;

constexpr size_t MiB = 1u << 20;
constexpr size_t WS_CTL = 0, CTL_ZERO_BYTES = 1 * MiB;
constexpr size_t WS_WIN = 2 * MiB, WS_WOUT = 9 * MiB, WS_WLORA = 11 * MiB;
constexpr size_t WS_WF = 12 * MiB, WS_WFD = WS_WF + 112 * MiB;
constexpr size_t WS_YS = WS_WF, WS_OP = WS_WF + 64 * MiB, WS_LSE = WS_WF + 160 * MiB;
constexpr size_t WS_XB = 180 * MiB, WS_VF = 244 * MiB, WS_BIG = 276 * MiB;
constexpr size_t WS_PROJ = WS_BIG, WS_SCANIN = WS_BIG + 224 * MiB, WS_G = WS_BIG + 608 * MiB;
constexpr size_t WS_MIX = WS_BIG, WS_Y = WS_BIG + 64 * MiB;
constexpr size_t WS_HID = WS_BIG, WS_XS = WS_BIG + 464 * MiB, WS_YPAIR = WS_XS, WS_Y2 = WS_XS;
constexpr size_t WS_ROWDST = WS_BIG + 600 * MiB, WS_ROWGATE = WS_BIG + 601 * MiB, WS_CHOICE = WS_BIG + 602 * MiB;
constexpr size_t WS_END = WS_BIG + 640 * MiB;
static_assert(WS_XS + (size_t)MOE_ROWS * D * 2 <= WS_ROWDST && WS_HID + (size_t)MOE_ROWS * DFE * 2 <= WS_XS, "ws map");
static_assert(WS_LSE + 3ull * M * 8 * 4 <= WS_XB && WS_SCANIN + (size_t)M * 8 * 384 * 4 <= WS_G, "ws map");
constexpr int CW_BAR = 4096;
constexpr int CW_MOE = 512;

constexpr int LDS_BYTES = 147456, RING_BYTES = 131072, MISC_OFF = RING_BYTES + 320;

struct Args { const float* in[29]; float* out; unsigned char* ws; int ph_lo, ph_hi; };

__device__ __forceinline__ float bf2f(unsigned short h) { return __builtin_bit_cast(float, (unsigned)h << 16); }
__device__ __forceinline__ float bflo(unsigned w) { return __builtin_bit_cast(float, w << 16); }
__device__ __forceinline__ float bfhi(unsigned w) { return __builtin_bit_cast(float, w & 0xffff0000u); }
__device__ __forceinline__ unsigned cvtpk(float lo, float hi) { return pg8::cvt_pk_bf16(lo, hi); }
typedef unsigned u32x2 __attribute__((ext_vector_type(2)));
template <int CTRL> __device__ __forceinline__ float dppf(float x) { return __builtin_bit_cast(float, __builtin_amdgcn_update_dpp(0, __builtin_bit_cast(int, x), CTRL, 0xf, 0xf, false)); }
__device__ __forceinline__ float red4(float x) { x += dppf<0xB1>(x); x += dppf<0x4E>(x); return x; }
__device__ __forceinline__ float red8(float x) { x = red4(x); x += dppf<0x141>(x); return x; }
__device__ __forceinline__ float red16(float x) { x = red8(x); x += dppf<0x140>(x); return x; }
__device__ __forceinline__ float wave_sum(float v) {
#pragma unroll
    for (int o = 1; o < 64; o <<= 1) v += __shfl_xor(v, o);
    return v;
}
__device__ __forceinline__ float fast_exp(float x) { return __builtin_amdgcn_exp2f(x * 1.4426950408889634f); }
__device__ __forceinline__ float fast_sigmoid(float x) { return __builtin_amdgcn_rcpf(1.0f + fast_exp(-x)); }
__device__ __forceinline__ float fast_tanh(float x) { const float e = fast_exp(-2.0f * fabsf(x)); const float t = (1.0f - e) * __builtin_amdgcn_rcpf(1.0f + e); return x < 0.f ? -t : t; }

__device__ __forceinline__ const float* inp(int k) {
    typedef const volatile unsigned long long __attribute__((address_space(4))) * kp_t;
    const unsigned long long v = *(kp_t)((const char __attribute__((address_space(4)))*)__builtin_amdgcn_kernarg_segment_ptr() + 8 * k);
    const unsigned lo = __builtin_amdgcn_readfirstlane((unsigned)v), hi = __builtin_amdgcn_readfirstlane((unsigned)(v >> 32));
    return (const float*)(((unsigned long long)hi << 32) | lo);
}
struct Frame {
    LAS unsigned char* lds;
    int tid, lane, wave, vcu, G;
    unsigned char* ws;
    float* out;
};

__device__ __forceinline__ void conv_item(const float* W, int K, int N, int k0, int n0, bf16* WT, int ldk, int orow0, float scale, LAS float* scr, int lane) {
#pragma unroll 8
    for (int i = 0; i < 32; ++i) { const int kk = 2 * i + (lane >> 5); if (k0 + kk < K) scr[kk * 33 + (lane & 31)] = W[(size_t)(k0 + kk) * N + n0 + (lane & 31)] * scale; }
    LDS_WAIT(); asm volatile("" ::: "memory");
    const int c = lane & 7;
    if (k0 + 8 * c < K) {
#pragma unroll
        for (int j = 0; j < 4; ++j) { const int n = (lane >> 3) + 8 * j; const LAS float* s = scr + (8 * c) * 33 + n;
            v4u o; o.x = cvtpk(s[0 * 33], s[1 * 33]); o.y = cvtpk(s[2 * 33], s[3 * 33]); o.z = cvtpk(s[4 * 33], s[5 * 33]); o.w = cvtpk(s[6 * 33], s[7 * 33]);
            *(GAS v4u*)(WT + (size_t)(orow0 + n) * ldk + k0 + 8 * c) = o; }
    }
    LDS_WAIT(); asm volatile("" ::: "memory");
}
__device__ __forceinline__ void conv_matrix(Frame& F, const float* W, int K, int N, bf16* WT, int ldk, int row_off, int mode_half, float scale_cols_lt, float scale) {
    LAS float* scr = (LAS float*)(F.lds + F.wave * 16384);
    const int gw = F.vcu * NWAVES + F.wave, NGW = F.G * NWAVES;
    const int nkb = (K + 63) / 64, nnb = N / 32, nit = nkb * nnb;
    for (int it = gw; it < nit; it += NGW) {
        const int kb = it / nnb, nb = it % nnb, n0 = 32 * nb;
        int orow0; if (mode_half < 0) orow0 = row_off + n0; else orow0 = row_off + 256 * (n0 >> 7) + (n0 & 127) + 128 * mode_half;
        const float sc = ((float)n0 < scale_cols_lt) ? scale : 1.0f;
        conv_item(W, K, N, 64 * kb, n0, WT, ldk, orow0, sc, scr, F.lane);
    }
}
__device__ __forceinline__ void conv_mixer_weights(Frame& F, int l) {
    bf16* WIN = (bf16*)(F.ws + WS_WIN); bf16* WOUT = (bf16*)(F.ws + WS_WOUT); bf16* WL = (bf16*)(F.ws + WS_WLORA);
    conv_matrix(F, inp(1) + (size_t)l * D * 3328, D, 3328, WIN, D, 0, -1, 512.f, 0.125f);
    if (l > 0) conv_matrix(F, inp(2) + (size_t)(l - 1) * D * 32, D, 32, WIN, D, 3328, -1, 0.f, 1.f);
    { const int r0 = (l > 0) ? 3360 : 3328; const size_t n16 = (size_t)(NPROJ - r0) * D * 2 / 16; GAS v4u* z = (GAS v4u*)(WIN + (size_t)r0 * D);
      for (size_t i = (size_t)F.vcu * 512 + F.tid; i < n16; i += (size_t)F.G * 512) z[i] = (v4u){0u, 0u, 0u, 0u}; }
    conv_matrix(F, inp(17) + (size_t)l * D * D, D, D, WOUT, D, 0, -1, 0.f, 1.f);
    conv_matrix(F, inp(5) + (size_t)l * 64 * HW, 64, HW, WL, 64, 0, -1, 0.f, 1.f);
    conv_matrix(F, inp(7) + (size_t)l * 64 * HW, 64, HW, WL + 512 * 64, 64, 0, -1, 0.f, 1.f);
    conv_matrix(F, inp(11) + (size_t)l * 128 * HW, 128, HW, WL + 2 * 512 * 64, 128, 0, -1, 0.f, 1.f);
    if (l > 0) conv_matrix(F, inp(9) + (size_t)(l - 1) * 32 * HW, 32, HW, WL + 2 * 512 * 64 + 512 * 128, 32, 0, -1, 0.f, 1.f);
}
__device__ __forceinline__ void conv_ffn_weights(Frame& F, int l) {
    bf16* WGU = (bf16*)(F.ws + WS_WF); bf16* WD = (bf16*)(F.ws + WS_WFD); const int i = l >> 1;
    if ((l & 1) == 0) {
        conv_matrix(F, inp(22) + (size_t)i * D * DFF, D, DFF, WGU, D, 0, 0, 0.f, 1.f);
        conv_matrix(F, inp(23) + (size_t)i * D * DFF, D, DFF, WGU, D, 0, 1, 0.f, 1.f);
        conv_matrix(F, inp(24) + (size_t)i * DFF * D, DFF, D, WD, DFF, 0, -1, 0.f, 1.f);
    } else {
        for (int e = 0; e < NEXP; ++e) {
            conv_matrix(F, inp(26) + ((size_t)i * NEXP + e) * D * DFE, D, DFE, WGU + (size_t)e * 2 * DFE * D, D, 0, 0, 0.f, 1.f);
            conv_matrix(F, inp(27) + ((size_t)i * NEXP + e) * D * DFE, D, DFE, WGU + (size_t)e * 2 * DFE * D, D, 0, 1, 0.f, 1.f);
            conv_matrix(F, inp(28) + ((size_t)i * NEXP + e) * DFE * D, DFE, D, WD + (size_t)e * D * DFE, DFE, 0, -1, 0.f, 1.f);
        }
    }
}
__device__ __forceinline__ void conv_x(Frame& F) {
    const GAS f32x4* x = (const GAS f32x4*)inp(0); GAS u32x2* o = (GAS u32x2*)(F.ws + WS_XB);
    for (size_t i = (size_t)F.vcu * 512 + F.tid; i < (size_t)M * D / 4; i += (size_t)F.G * 512) { const f32x4 v = x[i]; u32x2 w; w.x = cvtpk(v.x, v.y); w.y = cvtpk(v.z, v.w); o[i] = w; }
}

struct EpiSwiglu {
    static constexpr bool PERM = true, AFTER_DRAIN = false;
    bf16* O; int ldc;
    __device__ __forceinline__ void operator()(const pg8::f32x4 (&acc)[2][2][4][2], const pg8::Unit& u, int wr, int wc, int fr, int fq) const {
        const int row0 = u.pm * 256 + wr * 64 + fr, col0 = u.pn * 128 + wc * 32 + 8 * fq;
#pragma unroll
        for (int ai = 0; ai < 2; ++ai)
#pragma unroll
            for (int m = 0; m < 4; ++m) {
                bf16* rowp = O + (size_t)(row0 + ai * 128 + m * 16) * ldc + col0; float h[8];
#pragma unroll
                for (int n = 0; n < 2; ++n)
#pragma unroll
                    for (int i = 0; i < 4; ++i) { const float gt = acc[ai][0][m][n][i], up = acc[ai][1][m][n][i]; h[4 * n + i] = gt * fast_sigmoid(gt) * up; }
                v4u w; w.x = cvtpk(h[0], h[1]); w.y = cvtpk(h[2], h[3]); w.z = cvtpk(h[4], h[5]); w.w = cvtpk(h[6], h[7]);
                *(v4u*)rowp = w;
            }
    }
};
struct EpiMoeDown {
    static constexpr bool PERM = true, AFTER_DRAIN = false;
    bf16* O; const int* rowdst; const float* rowgate;
    __device__ __forceinline__ void operator()(const pg8::f32x4 (&acc)[2][2][4][2], const pg8::Unit& u, int wr, int wc, int fr, int fq) const {
        const int row0 = u.pm * 256 + wr * 64 + fr, col0 = u.pn * 256 + wc * 32 + 8 * fq;
#pragma unroll
        for (int ai = 0; ai < 2; ++ai)
#pragma unroll
            for (int m = 0; m < 4; ++m) {
                const int slot = row0 + ai * 128 + m * 16; const int dst = rowdst[slot]; const float gt = rowgate[slot];
                if (dst >= 0) { bf16* rowp = O + (size_t)dst * D + col0;
#pragma unroll
                    for (int bj = 0; bj < 2; ++bj) { const pg8::f32x4 v0 = acc[ai][bj][m][0] * gt, v1 = acc[ai][bj][m][1] * gt;
                        v4u w; w.x = cvtpk(v0[0], v0[1]); w.y = cvtpk(v0[2], v0[3]); w.z = cvtpk(v1[0], v1[1]); w.w = cvtpk(v1[2], v1[3]);
                        *(v4u*)(rowp + bj * 128) = w; } }
            }
    }
};
struct GroupedOrder {
    int nN, G, c, nMt; int t1, t2, t3, t4, t5, t6, t7; unsigned estride;
    __device__ __forceinline__ void init(const unsigned* cnt, int nN_, int G_, int c_, unsigned estride_) {
        nN = nN_; G = G_; c = c_; estride = estride_;
#define RFL(x) __builtin_amdgcn_readfirstlane((int)(x))
        int t = 0; t += RFL((cnt[0] + 255u) >> 8); t1 = t; t += RFL((cnt[1] + 255u) >> 8); t2 = t; t += RFL((cnt[2] + 255u) >> 8); t3 = t; t += RFL((cnt[3] + 255u) >> 8); t4 = t;
        t += RFL((cnt[4] + 255u) >> 8); t5 = t; t += RFL((cnt[5] + 255u) >> 8); t6 = t; t += RFL((cnt[6] + 255u) >> 8); t7 = t; t += RFL((cnt[7] + 255u) >> 8); nMt = t;
    }
    __device__ __forceinline__ bool next(int i, pg8::Unit& u) const {
        const long L = (long)i * G + c; if (L >= (long)nMt * nN) return false;
        const int pm = (int)(L / nN), pn = (int)(L % nN);
        const int e = (pm >= t1) + (pm >= t2) + (pm >= t3) + (pm >= t4) + (pm >= t5) + (pm >= t6) + (pm >= t7);
        u.pm = pm; u.pn = pn; u.bofs = (unsigned)e * estride; return true;
    }
    __device__ __forceinline__ void a_ready(const pg8::Unit&) const {}
    __device__ __forceinline__ void done(const pg8::Unit&) const {}
};

__device__ __forceinline__ void prep_phase(Frame& F, int l) {
    const bf16* PROJ = (const bf16*)(F.ws + WS_PROJ); float* SC = (float*)(F.ws + WS_SCANIN); bf16* GB = (bf16*)(F.ws + WS_G); bf16* VF = (bf16*)(F.ws + WS_VF);
    const bf16* WL = (const bf16*)(F.ws + WS_WLORA);
    const float* mu = inp(3) + (size_t)l * 1792; const float* muv = inp(4) + (size_t)(l > 0 ? l - 1 : 0) * 32;
    const int gw = F.vcu * NWAVES + F.wave, NGW = F.G * NWAVES;
    const int lane = F.lane, g = lane >> 4, c = lane & 15;
    const int h = gw & 7; const int colh = 64 * h + 4 * c;
    f32x4 mu_r = *(const f32x4*)(mu + colh), mu_k = *(const f32x4*)(mu + 512 + colh), mu_v = *(const f32x4*)(mu + 1024 + colh);
    f32x4 dbase = *(const f32x4*)(inp(6) + (size_t)l * HW + colh), abase = *(const f32x4*)(inp(8) + (size_t)l * HW + colh);
    f32x4 vbase = (l > 0) ? *(const f32x4*)(inp(10) + (size_t)(l - 1) * HW + colh) : (f32x4){0.f, 0.f, 0.f, 0.f};
    f32x4 kkp = *(const f32x4*)(inp(12) + (size_t)l * HW + colh), kap = *(const f32x4*)(inp(13) + (size_t)l * HW + colh);
    const int nkb = (l > 0) ? 9 : 8;
    for (int wu = gw; wu < (M / 16) * 8; wu += NGW) {
        const int tile = wu >> 3; const int tok0 = tile * 16;
        pg8::bf16x8 Aop[9];
        { const int m = tok0 + c; const bool first = (m & (SEQ - 1)) == 0;
          const bf16* pc = PROJ + (size_t)m * NPROJ + 3072 + 8 * g; const bf16* pp = pc - NPROJ;
#pragma unroll
          for (int kb = 0; kb < 9; ++kb) {
              if (kb < nkb) {
                  const v4u cu = *(const v4u*)(pc + 32 * kb); v4u pv = (v4u){0u, 0u, 0u, 0u}; if (!first) pv = *(const v4u*)(pp + 32 * kb);
                  const float* mp = (kb < 8) ? (mu + 1536 + 32 * kb + 8 * g) : (muv + 8 * g);
                  const f32x4 m0 = *(const f32x4*)mp, m1 = *(const f32x4*)(mp + 4);
                  float v[8];
                  v[0] = bflo(cu.x); v[1] = bfhi(cu.x); v[2] = bflo(cu.y); v[3] = bfhi(cu.y); v[4] = bflo(cu.z); v[5] = bfhi(cu.z); v[6] = bflo(cu.w); v[7] = bfhi(cu.w);
                  float p[8];
                  p[0] = bflo(pv.x); p[1] = bfhi(pv.x); p[2] = bflo(pv.y); p[3] = bfhi(pv.y); p[4] = bflo(pv.z); p[5] = bfhi(pv.z); p[6] = bflo(pv.w); p[7] = bfhi(pv.w);
#pragma unroll
                  for (int j = 0; j < 8; ++j) { const float mm = (j < 4) ? m0[j & 3] : m1[j & 3]; float x = v[j] + (p[j] - v[j]) * mm;
                      if (kb < 2) x = fast_tanh(x); else if (kb >= 4 && kb < 8) x = fast_sigmoid(x); v[j] = x; }
                  v4u o; o.x = cvtpk(v[0], v[1]); o.y = cvtpk(v[2], v[3]); o.z = cvtpk(v[4], v[5]); o.w = cvtpk(v[6], v[7]);
                  Aop[kb] = __builtin_bit_cast(pg8::bf16x8, o);
              } else Aop[kb] = (pg8::bf16x8){0, 0, 0, 0, 0, 0, 0, 0};
          } }
        pg8::f32x4 aw[4], aa[4], ag[4], av[4];
#pragma unroll
        for (int nt = 0; nt < 4; ++nt) {
            const int n = colh + nt;
            pg8::f32x4 z = (pg8::f32x4){0.f, 0.f, 0.f, 0.f}; aw[nt] = z; aa[nt] = z; ag[nt] = z; av[nt] = z;
#pragma unroll
            for (int kb = 0; kb < 2; ++kb) { const pg8::bf16x8 b = *(const pg8::bf16x8*)(WL + (size_t)n * 64 + 32 * kb + 8 * g); aw[nt] = __builtin_amdgcn_mfma_f32_16x16x32_bf16(Aop[kb], b, aw[nt], 0, 0, 0); }
#pragma unroll
            for (int kb = 0; kb < 2; ++kb) { const pg8::bf16x8 b = *(const pg8::bf16x8*)(WL + 512 * 64 + (size_t)n * 64 + 32 * kb + 8 * g); aa[nt] = __builtin_amdgcn_mfma_f32_16x16x32_bf16(Aop[2 + kb], b, aa[nt], 0, 0, 0); }
#pragma unroll
            for (int kb = 0; kb < 4; ++kb) { const pg8::bf16x8 b = *(const pg8::bf16x8*)(WL + 2 * 512 * 64 + (size_t)n * 128 + 32 * kb + 8 * g); ag[nt] = __builtin_amdgcn_mfma_f32_16x16x32_bf16(Aop[4 + kb], b, ag[nt], 0, 0, 0); }
            if (l > 0) { const pg8::bf16x8 b = *(const pg8::bf16x8*)(WL + 2 * 512 * 64 + 512 * 128 + (size_t)n * 32 + 8 * g); av[nt] = __builtin_amdgcn_mfma_f32_16x16x32_bf16(Aop[8], b, av[nt], 0, 0, 0); }
        }
        float rr[4][4], kk_[4][4], vv[4][4];
        { const int m0 = tok0 + 4 * g; const bf16* base = PROJ + (size_t)m0 * NPROJ + 1536 + colh;
          u32x2 pr = (u32x2){0u, 0u}, pk = pr, pvv = pr;
          if ((m0 & (SEQ - 1)) != 0) { pr = *(const u32x2*)(base - NPROJ); pk = *(const u32x2*)(base - NPROJ + 512); pvv = *(const u32x2*)(base - NPROJ + 1024); }
#pragma unroll
          for (int e = 0; e < 4; ++e) {
              const u32x2 cr = *(const u32x2*)(base + (size_t)e * NPROJ), ck = *(const u32x2*)(base + (size_t)e * NPROJ + 512), cv = *(const u32x2*)(base + (size_t)e * NPROJ + 1024);
              const float c0[4] = {bflo(cr.x), bfhi(cr.x), bflo(cr.y), bfhi(cr.y)}, p0[4] = {bflo(pr.x), bfhi(pr.x), bflo(pr.y), bfhi(pr.y)};
              const float c1[4] = {bflo(ck.x), bfhi(ck.x), bflo(ck.y), bfhi(ck.y)}, p1[4] = {bflo(pk.x), bfhi(pk.x), bflo(pk.y), bfhi(pk.y)};
              const float c2[4] = {bflo(cv.x), bfhi(cv.x), bflo(cv.y), bfhi(cv.y)}, p2[4] = {bflo(pvv.x), bfhi(pvv.x), bflo(pvv.y), bfhi(pvv.y)};
#pragma unroll
              for (int nt = 0; nt < 4; ++nt) { rr[e][nt] = c0[nt] + (p0[nt] - c0[nt]) * mu_r[nt]; kk_[e][nt] = c1[nt] + (p1[nt] - c1[nt]) * mu_k[nt]; vv[e][nt] = c2[nt] + (p2[nt] - c2[nt]) * mu_v[nt]; }
              pr = cr; pk = ck; pvv = cv;
          } }
#pragma unroll
        for (int e = 0; e < 4; ++e) {
            const int m = tok0 + 4 * g + e; const int b = m >> 12, t = m & (SEQ - 1);
            float w4[4], a4[4], kr[4], kn[4], bb[4], k2[4], v2[4];
            float ss = 0.f;
#pragma unroll
            for (int nt = 0; nt < 4; ++nt) {
                w4[nt] = fast_exp(-0.6065306597126334f * fast_sigmoid(dbase[nt] + aw[nt][e]));
                a4[nt] = fast_sigmoid(abase[nt] + aa[nt][e]);
                kr[nt] = kk_[e][nt] * kkp[nt]; ss += kr[nt] * kr[nt];
            }
            ss = red16(ss);
            const float inv = 1.0f / fmaxf(sqrtf(ss), 1e-12f);
            u32x2 vf2 = (u32x2){0u, 0u}; if (l > 0) vf2 = *(const u32x2*)(VF + (size_t)m * HW + colh);
            const float vf[4] = {bflo(vf2.x), bfhi(vf2.x), bflo(vf2.y), bfhi(vf2.y)};
#pragma unroll
            for (int nt = 0; nt < 4; ++nt) {
                kn[nt] = kr[nt] * inv; bb[nt] = kn[nt] * a4[nt];
                k2[nt] = kk_[e][nt] * (1.0f + (a4[nt] - 1.0f) * kap[nt]);
                v2[nt] = (l > 0) ? vv[e][nt] + (vf[nt] - vv[e][nt]) * fast_sigmoid(vbase[nt] + av[nt][e]) : vv[e][nt];
            }
            float* sp = SC + ((size_t)(b * 8 + h) * SEQ + t) * 384 + 4 * c;
            *(f32x4*)(sp) = (f32x4){w4[0], w4[1], w4[2], w4[3]};
            *(f32x4*)(sp + 64) = (f32x4){kn[0], kn[1], kn[2], kn[3]};
            *(f32x4*)(sp + 128) = (f32x4){bb[0], bb[1], bb[2], bb[3]};
            *(f32x4*)(sp + 192) = (f32x4){k2[0], k2[1], k2[2], k2[3]};
            *(f32x4*)(sp + 256) = (f32x4){rr[e][0], rr[e][1], rr[e][2], rr[e][3]};
            *(f32x4*)(sp + 320) = (f32x4){v2[0], v2[1], v2[2], v2[3]};
            u32x2 go; go.x = cvtpk(ag[0][e], ag[1][e]); go.y = cvtpk(ag[2][e], ag[3][e]);
            *(u32x2*)(GB + (size_t)m * HW + colh) = go;
            if (l == 0) { u32x2 vo; vo.x = cvtpk(vv[e][0], vv[e][1]); vo.y = cvtpk(vv[e][2], vv[e][3]); *(u32x2*)(VF + (size_t)m * HW + colh) = vo; }
        }
    }
}

constexpr int SC_T = 32, SC_BUF = SC_T * 384 * 4, SC_YOFF = 2 * SC_BUF, SC_YBUF = SC_T * 16 * 4;
__device__ __forceinline__ void scan_phase(Frame& F) {
    const float* SC = (const float*)(F.ws + WS_SCANIN); float* YS = (float*)(F.ws + WS_YS);
    const int lane = F.lane, w = F.wave;
    for (int unit = F.vcu; unit < 256; unit += F.G) {
        const int bh = unit >> 2, q = unit & 3, b = bh >> 3, h = bh & 7;
        const float* src = SC + (size_t)bh * SEQ * 384;
        const int lt = F.tid - 256;
        __syncthreads();
        if (w >= 4) {
#pragma unroll
            for (int i = 0; i < 12; ++i) { const f32x4 v = *(const GAS f32x4*)(src + (size_t)(i * 256 + lt) * 4); *(LAS f32x4*)(F.lds + (size_t)(i * 256 + lt) * 16) = v; }
        }
        __syncthreads();
        float S0 = 0.f, S1 = 0.f, S2 = 0.f, S3 = 0.f;
        const int i4 = lane >> 4, j = lane & 15;
        for (int ch = 0; ch < SEQ / SC_T; ++ch) {
            if (w >= 4) {
                if (ch + 1 < SEQ / SC_T) {
                    const float* s2 = src + (size_t)(ch + 1) * SC_T * 384; f32x4 v[12];
#pragma unroll
                    for (int i = 0; i < 12; ++i) v[i] = *(const GAS f32x4*)(s2 + (size_t)(i * 256 + lt) * 4);
                    LAS unsigned char* dst = F.lds + ((ch + 1) & 1) * SC_BUF;
#pragma unroll
                    for (int i = 0; i < 12; ++i) *(LAS f32x4*)(dst + (size_t)(i * 256 + lt) * 16) = v[i];
                }
                if (ch > 0 && lt < 128) { const int t = lt >> 2, part = lt & 3;
                    const f32x4 y = *(const LAS f32x4*)(F.lds + SC_YOFF + ((ch - 1) & 1) * SC_YBUF + (t * 16 + 4 * part) * 4);
                    *(GAS f32x4*)(YS + ((size_t)b * SEQ + (ch - 1) * SC_T + t) * HW + 64 * h + 16 * q + 4 * part) = y; }
            } else {
                const LAS unsigned char* buf = F.lds + (ch & 1) * SC_BUF; LAS float* yb = (LAS float*)(F.lds + SC_YOFF + (ch & 1) * SC_YBUF);
#pragma unroll 8
                for (int t = 0; t < SC_T; ++t) {
                    const LAS unsigned char* p = buf + t * 1536 + 16 * j;
                    const f32x4 wv = *(const LAS f32x4*)(p), kkv = *(const LAS f32x4*)(p + 256), bv = *(const LAS f32x4*)(p + 512), kv = *(const LAS f32x4*)(p + 768), rv = *(const LAS f32x4*)(p + 1024);
                    const float vr = *(const LAS float*)(buf + t * 1536 + 1280 + (16 * q + 4 * w + i4) * 4);
                    float pa = S0 * kkv.x + S1 * kkv.y + S2 * kkv.z + S3 * kkv.w;
                    const float sa = -red16(pa);
                    S0 = S0 * wv.x + sa * bv.x + vr * kv.x; S1 = S1 * wv.y + sa * bv.y + vr * kv.y; S2 = S2 * wv.z + sa * bv.z + vr * kv.z; S3 = S3 * wv.w + sa * bv.w + vr * kv.w;
                    float py = S0 * rv.x + S1 * rv.y + S2 * rv.z + S3 * rv.w;
                    py = red16(py);
                    if (j == 0) yb[t * 16 + 4 * w + i4] = py;
                }
            }
            __syncthreads();
        }
        if (w >= 4 && lt < 128) { const int ch = SEQ / SC_T; const int t = lt >> 2, part = lt & 3;
            const f32x4 y = *(const LAS f32x4*)(F.lds + SC_YOFF + ((ch - 1) & 1) * SC_YBUF + (t * 16 + 4 * part) * 4);
            *(GAS f32x4*)(YS + ((size_t)b * SEQ + (ch - 1) * SC_T + t) * HW + 64 * h + 16 * q + 4 * part) = y; }
    }
}

constexpr int AT_PITCH = 144, AT_KOFF = 0, AT_VOFF = 40960;
__device__ __forceinline__ void attn_phase(Frame& F) {
    const bf16* PROJ = (const bf16*)(F.ws + WS_PROJ); bf16* OP = (bf16*)(F.ws + WS_OP); float* LSE = (float*)(F.ws + WS_LSE);
    const int lane = F.lane, w = F.wave, g = lane >> 4, c16 = lane & 15, tid = F.tid;
    LAS unsigned char* Ks = F.lds + AT_KOFF; LAS unsigned char* Vs = F.lds + AT_VOFF;
    __syncthreads();
    for (int i = tid; i < 16 * AT_PITCH / 4; i += 512) { ((LAS unsigned*)(Ks + 256 * AT_PITCH))[i] = 0u; ((LAS unsigned*)(Vs + 256 * AT_PITCH))[i] = 0u; }
    for (int u = F.vcu; u < 3 * 2048; u += F.G) {
        const int p = u >> 11, r = u & 2047; const int dil = 1 << (2 * p), nb = 32 >> (2 * p);
        const int n = r % nb, cls = (r / nb) % dil, bh = r >> 5, b = bh >> 3, h = bh & 7;
        __syncthreads();
        { const int row = tid >> 1, half = tid & 1; const int idx = 128 * (n - 1) + row;
          v4u kq[4], vq[4];
          if (idx >= 0) { const bf16* kp = PROJ + ((size_t)b * SEQ + (size_t)idx * dil + cls) * NPROJ + 512 + 64 * h + 32 * half;
#pragma unroll
              for (int i = 0; i < 4; ++i) { kq[i] = *(const v4u*)(kp + 8 * i); vq[i] = *(const v4u*)(kp + 512 + 8 * i); } }
          else {
#pragma unroll
              for (int i = 0; i < 4; ++i) { kq[i] = (v4u){0u, 0u, 0u, 0u}; vq[i] = (v4u){0u, 0u, 0u, 0u}; } }
#pragma unroll
          for (int i = 0; i < 4; ++i) { *(LAS v4u*)(Ks + row * AT_PITCH + 64 * half + 16 * i) = kq[i]; *(LAS v4u*)(Vs + row * AT_PITCH + 64 * half + 16 * i) = vq[i]; } }
        const int qidx = 128 * n + 16 * w + c16; const size_t mq = (size_t)b * SEQ + (size_t)qidx * dil + cls;
        pg8::bf16x8 qf[2];
        { const bf16* qp = PROJ + mq * NPROJ + 64 * h + 8 * g; qf[0] = *(const pg8::bf16x8*)qp; qf[1] = *(const pg8::bf16x8*)(qp + 32); }
        __syncthreads();
        pg8::f32x4 s[9];
#pragma unroll
        for (int jt = 0; jt < 9; ++jt) {
            const LAS unsigned char* kp = Ks + (16 * w + 16 * jt + c16) * AT_PITCH + 16 * g;
            const pg8::bf16x8 k0 = *(const LAS pg8::bf16x8*)kp, k1 = *(const LAS pg8::bf16x8*)(kp + 64);
            pg8::f32x4 a = (pg8::f32x4){0.f, 0.f, 0.f, 0.f};
            a = __builtin_amdgcn_mfma_f32_16x16x32_bf16(k0, qf[0], a, 0, 0, 0);
            a = __builtin_amdgcn_mfma_f32_16x16x32_bf16(k1, qf[1], a, 0, 0, 0);
            s[jt] = a;
        }
        const float NEG = -INFINITY; float mx = NEG;
#pragma unroll
        for (int jt = 0; jt < 9; ++jt)
#pragma unroll
            for (int e = 0; e < 4; ++e) { const int kw = 16 * w + 16 * jt + 4 * g + e; const int qw = 128 + 16 * w + c16;
                bool ok = true; if (jt == 0) ok = kw >= qw - 128; if (jt == 8) ok = kw <= qw; if (n == 0) ok = ok && (kw >= 128);
                if (!ok) s[jt][e] = NEG; mx = fmaxf(mx, s[jt][e]); }
        mx = fmaxf(mx, __shfl_xor(mx, 16)); mx = fmaxf(mx, __shfl_xor(mx, 32));
        float lsum = 0.f;
#pragma unroll
        for (int jt = 0; jt < 9; ++jt)
#pragma unroll
            for (int e = 0; e < 4; ++e) { const float pe = __builtin_amdgcn_exp2f((s[jt][e] - mx) * 1.4426950408889634f); s[jt][e] = pe; lsum += pe; }
        lsum += __shfl_xor(lsum, 16); lsum += __shfl_xor(lsum, 32);
        pg8::f32x4 o[4];
#pragma unroll
        for (int dt = 0; dt < 4; ++dt) o[dt] = (pg8::f32x4){0.f, 0.f, 0.f, 0.f};
#pragma unroll
        for (int jp = 0; jp < 5; ++jp) {
            v4u pw; pw.x = cvtpk(s[2 * jp][0], s[2 * jp][1]); pw.y = cvtpk(s[2 * jp][2], s[2 * jp][3]);
            if (jp < 4) { pw.z = cvtpk(s[2 * jp + 1][0], s[2 * jp + 1][1]); pw.w = cvtpk(s[2 * jp + 1][2], s[2 * jp + 1][3]); } else { pw.z = 0u; pw.w = 0u; }
            const pg8::bf16x8 pf = __builtin_bit_cast(pg8::bf16x8, pw);
            const unsigned va = (unsigned)(size_t)(Vs + (16 * w + 32 * jp + 4 * g + (c16 >> 2)) * AT_PITCH + 8 * (c16 & 3));
#pragma unroll
            for (int dt = 0; dt < 4; ++dt) {
                u32x2 lo, hi;
                asm volatile("ds_read_b64_tr_b16 %0, %2 offset:%c3\n\tds_read_b64_tr_b16 %1, %2 offset:%c4\n\ts_waitcnt lgkmcnt(0)" : "=&v"(lo), "=&v"(hi) : "v"(va), "i"(32 * dt), "i"(32 * dt + 16 * AT_PITCH) : "memory");
                v4u vw; vw.x = lo.x; vw.y = lo.y; vw.z = hi.x; vw.w = hi.y;
                o[dt] = __builtin_amdgcn_mfma_f32_16x16x32_bf16(__builtin_bit_cast(pg8::bf16x8, vw), pf, o[dt], 0, 0, 0);
            }
        }
        const float il = 1.0f / lsum;
        bf16* op = OP + ((size_t)p * M + mq) * HW + 64 * h + 4 * g;
#pragma unroll
        for (int dt = 0; dt < 4; ++dt) { u32x2 ow; ow.x = cvtpk(o[dt][0] * il, o[dt][1] * il); ow.y = cvtpk(o[dt][2] * il, o[dt][3] * il); *(u32x2*)(op + 16 * dt) = ow; }
        if (g == 0) LSE[((size_t)p * M + mq) * 8 + h] = mx + __logf(lsum);
    }
}

__device__ __forceinline__ void post_phase(Frame& F, int l) {
    const float* YS = (const float*)(F.ws + WS_YS); const float* SC = (const float*)(F.ws + WS_SCANIN); const bf16* GB = (const bf16*)(F.ws + WS_G);
    const bf16* OP = (const bf16*)(F.ws + WS_OP); const float* LSE = (const float*)(F.ws + WS_LSE); bf16* MIX = (bf16*)(F.ws + WS_MIX);
    const int lane = F.lane, gw = F.vcu * NWAVES + F.wave, NGW = F.G * NWAVES;
    const int h = lane >> 3, c8 = 8 * (lane & 7);
    f32x4 lg0 = *(const f32x4*)(inp(15) + (size_t)l * HW + 8 * lane), lg1 = *(const f32x4*)(inp(15) + (size_t)l * HW + 8 * lane + 4);
    f32x4 lb0 = *(const f32x4*)(inp(16) + (size_t)l * HW + 8 * lane), lb1 = *(const f32x4*)(inp(16) + (size_t)l * HW + 8 * lane + 4);
    f32x4 rk0 = *(const f32x4*)(inp(14) + (size_t)l * HW + 8 * lane), rk1 = *(const f32x4*)(inp(14) + (size_t)l * HW + 8 * lane + 4);
    for (int m = gw; m < M; m += NGW) {
        const int b = m >> 12, t = m & (SEQ - 1);
        float o8[8];
        { const float l0 = LSE[((size_t)0 * M + m) * 8 + h], l1 = LSE[((size_t)1 * M + m) * 8 + h], l2 = LSE[((size_t)2 * M + m) * 8 + h];
          const float mx = fmaxf(l0, fmaxf(l1, l2)); float w0 = fast_exp(l0 - mx), w1 = fast_exp(l1 - mx), w2 = fast_exp(l2 - mx); const float inv = 1.0f / (w0 + w1 + w2); w0 *= inv; w1 *= inv; w2 *= inv;
          const v4u a0 = *(const v4u*)(OP + ((size_t)0 * M + m) * HW + 8 * lane), a1 = *(const v4u*)(OP + ((size_t)1 * M + m) * HW + 8 * lane), a2 = *(const v4u*)(OP + ((size_t)2 * M + m) * HW + 8 * lane);
          const unsigned* p0 = (const unsigned*)&a0; const unsigned* p1 = (const unsigned*)&a1; const unsigned* p2 = (const unsigned*)&a2;
#pragma unroll
          for (int i = 0; i < 4; ++i) { o8[2 * i] = w0 * bflo(p0[i]) + w1 * bflo(p1[i]) + w2 * bflo(p2[i]); o8[2 * i + 1] = w0 * bfhi(p0[i]) + w1 * bfhi(p1[i]) + w2 * bfhi(p2[i]); } }
        v4u oa; oa.x = cvtpk(o8[0], o8[1]); oa.y = cvtpk(o8[2], o8[3]); oa.z = cvtpk(o8[4], o8[5]); oa.w = cvtpk(o8[6], o8[7]);
        *(v4u*)(MIX + (size_t)m * D + 8 * lane) = oa;
        const f32x4 y0 = *(const f32x4*)(YS + (size_t)m * HW + 8 * lane), y1 = *(const f32x4*)(YS + (size_t)m * HW + 8 * lane + 4);
        const float* sp = SC + ((size_t)(b * 8 + h) * SEQ + t) * 384 + c8;
        const f32x4 k0 = *(const f32x4*)(sp + 192), k1 = *(const f32x4*)(sp + 196), r0 = *(const f32x4*)(sp + 256), r1 = *(const f32x4*)(sp + 260), v0 = *(const f32x4*)(sp + 320), v1 = *(const f32x4*)(sp + 324);
        const v4u gq = *(const v4u*)(GB + (size_t)m * HW + 8 * lane);
        float s = (y0.x + y0.y) + (y0.z + y0.w) + (y1.x + y1.y) + (y1.z + y1.w); s = red8(s);
        const float mean = s * (1.0f / 64.0f);
        const f32x4 d0 = y0 - mean, d1 = y1 - mean;
        float qv = (d0.x * d0.x + d0.y * d0.y) + (d0.z * d0.z + d0.w * d0.w) + (d1.x * d1.x + d1.y * d1.y) + (d1.z * d1.z + d1.w * d1.w); qv = red8(qv);
        const float rstd = 1.0f / sqrtf(qv * (1.0f / 64.0f) + GN_EPS);
        float bs = (r0.x * k0.x * rk0.x + r0.y * k0.y * rk0.y) + (r0.z * k0.z * rk0.z + r0.w * k0.w * rk0.w) + (r1.x * k1.x * rk1.x + r1.y * k1.y * rk1.y) + (r1.z * k1.z * rk1.z + r1.w * k1.w * rk1.w); bs = red8(bs);
        const f32x4 yn0 = d0 * rstd * lg0 + lb0 + v0 * bs, yn1 = d1 * rstd * lg1 + lb1 + v1 * bs;
        v4u ob; ob.x = cvtpk(yn0.x * bflo(gq.x), yn0.y * bfhi(gq.x)); ob.y = cvtpk(yn0.z * bflo(gq.y), yn0.w * bfhi(gq.y)); ob.z = cvtpk(yn1.x * bflo(gq.z), yn1.y * bfhi(gq.z)); ob.w = cvtpk(yn1.z * bflo(gq.w), yn1.w * bfhi(gq.w));
        *(v4u*)(MIX + (size_t)m * D + HW + 8 * lane) = ob;
    }
}

template <int MODE, bool ROUTE, bool LAST>
__device__ __forceinline__ void ln_phase(Frame& F, const bf16* Yb, const float* gam, const float* bet, const float* router, unsigned* cnt) {
    bf16* XB = (bf16*)(F.ws + WS_XB);
    const int lane = F.lane, gw = F.vcu * NWAVES + F.wave, NGW = F.G * NWAVES;
    f32x4 gv[4], bv[4];
#pragma unroll
    for (int j = 0; j < 4; ++j) { gv[j] = *(const f32x4*)(gam + 4 * lane + 256 * j); bv[j] = *(const f32x4*)(bet + 4 * lane + 256 * j); }
    for (int m = gw; m < M; m += NGW) {
        f32x4 z[4]; float s = 0.f;
#pragma unroll
        for (int j = 0; j < 4; ++j) {
            const u32x2 xa = *(const u32x2*)(XB + (size_t)m * D + 4 * lane + 256 * j);
            f32x4 f;
            if (MODE == 0) { const u32x2 ya = *(const u32x2*)(Yb + (size_t)m * D + 4 * lane + 256 * j); f = (f32x4){bflo(ya.x), bfhi(ya.x), bflo(ya.y), bfhi(ya.y)}; }
            else { const u32x2 ya = *(const u32x2*)(Yb + (size_t)(2 * m) * D + 4 * lane + 256 * j), yb = *(const u32x2*)(Yb + (size_t)(2 * m + 1) * D + 4 * lane + 256 * j);
                   f = (f32x4){bflo(ya.x) + bflo(yb.x), bfhi(ya.x) + bfhi(yb.x), bflo(ya.y) + bflo(yb.y), bfhi(ya.y) + bfhi(yb.y)}; }
            z[j] = (f32x4){bflo(xa.x), bfhi(xa.x), bflo(xa.y), bfhi(xa.y)} * DN_ALPHA + f;
            s += (z[j].x + z[j].y) + (z[j].z + z[j].w);
        }
        const float mean = wave_sum(s) * (1.0f / D); float s2 = 0.f;
#pragma unroll
        for (int j = 0; j < 4; ++j) { z[j] = z[j] - mean; s2 += (z[j].x * z[j].x + z[j].y * z[j].y) + (z[j].z * z[j].z + z[j].w * z[j].w); }
        const float rstd = 1.0f / sqrtf(wave_sum(s2) * (1.0f / D) + LN_EPS);
#pragma unroll
        for (int j = 0; j < 4; ++j) z[j] = z[j] * rstd * gv[j] + bv[j];
        if (LAST) {
#pragma unroll
            for (int j = 0; j < 4; ++j) *(GAS f32x4*)(F.out + (size_t)m * D + 4 * lane + 256 * j) = z[j];
        } else {
#pragma unroll
            for (int j = 0; j < 4; ++j) { u32x2 o; o.x = cvtpk(z[j].x, z[j].y); o.y = cvtpk(z[j].z, z[j].w); *(u32x2*)(XB + (size_t)m * D + 4 * lane + 256 * j) = o; }
        }
        if (ROUTE) {
            float lg[8];
#pragma unroll
            for (int e = 0; e < 8; ++e) lg[e] = 0.f;
#pragma unroll
            for (int j = 0; j < 4; ++j)
#pragma unroll
                for (int i = 0; i < 4; ++i) { const float xv = z[j][i]; const float* rp = router + (size_t)(4 * lane + 256 * j + i) * 8; const f32x4 ra = *(const f32x4*)rp, rb = *(const f32x4*)(rp + 4);
                    lg[0] += xv * ra.x; lg[1] += xv * ra.y; lg[2] += xv * ra.z; lg[3] += xv * ra.w; lg[4] += xv * rb.x; lg[5] += xv * rb.y; lg[6] += xv * rb.z; lg[7] += xv * rb.w; }
#pragma unroll
            for (int e = 0; e < 8; ++e) lg[e] = wave_sum(lg[e]);
            int e0 = 0; float v0 = lg[0];
#pragma unroll
            for (int e = 1; e < 8; ++e) if (lg[e] > v0) { v0 = lg[e]; e0 = e; }
            int e1 = -1; float v1 = -INFINITY;
#pragma unroll
            for (int e = 0; e < 8; ++e) if (e != e0 && lg[e] > v1) { v1 = lg[e]; e1 = e; }
            if (lane == 0) {
                const float g1 = 1.0f / (1.0f + __expf(v0 - v1)), g0 = 1.0f - g1;
                const unsigned p0 = atomicAdd(cnt + e0, 1u), p1 = atomicAdd(cnt + e1, 1u);
                int* ch = (int*)(F.ws + WS_CHOICE) + (size_t)m * 8;
                ch[0] = e0; ch[1] = e1; ch[2] = (int)p0; ch[3] = (int)p1; ((float*)ch)[4] = g0; ((float*)ch)[5] = g1;
            }
        }
    }
}

__device__ __forceinline__ void moe_build_phase(Frame& F, const unsigned* cnt) {
    const bf16* XB = (const bf16*)(F.ws + WS_XB); bf16* XS = (bf16*)(F.ws + WS_XS); int* RD = (int*)(F.ws + WS_ROWDST); float* RG = (float*)(F.ws + WS_ROWGATE);
    const int lane = F.lane, gw = F.vcu * NWAVES + F.wave, NGW = F.G * NWAVES;
    int off[9]; off[0] = 0;
#pragma unroll
    for (int e = 0; e < 8; ++e) off[e + 1] = off[e] + (int)(((cnt[e] + 255u) >> 8) << 8);
    for (int m = gw; m < M; m += NGW) {
        const int* ch = (const int*)(F.ws + WS_CHOICE) + (size_t)m * 8;
        const int e0 = ch[0], e1 = ch[1], p0 = ch[2], p1 = ch[3]; const float g0 = ((const float*)ch)[4], g1 = ((const float*)ch)[5];
        int o0 = 0, o1 = 0;
#pragma unroll
        for (int e = 0; e < 8; ++e) { if (e == e0) o0 = off[e]; if (e == e1) o1 = off[e]; }
        const int s0 = o0 + p0, s1 = o1 + p1;
        const v4u a = *(const v4u*)(XB + (size_t)m * D + 8 * lane), b2 = *(const v4u*)(XB + (size_t)m * D + 512 + 8 * lane);
        *(v4u*)(XS + (size_t)s0 * D + 8 * lane) = a; *(v4u*)(XS + (size_t)s0 * D + 512 + 8 * lane) = b2;
        *(v4u*)(XS + (size_t)s1 * D + 8 * lane) = a; *(v4u*)(XS + (size_t)s1 * D + 512 + 8 * lane) = b2;
        if (lane == 0) { RD[s0] = 2 * m; RG[s0] = g0; RD[s1] = 2 * m + 1; RG[s1] = g1; }
    }
#pragma unroll
    for (int e = 0; e < 8; ++e) {
        const int lo = off[e] + (int)cnt[e], hi = off[e + 1];
        for (int s = lo + gw; s < hi; s += NGW) { *(v4u*)(XS + (size_t)s * D + 8 * lane) = (v4u){0u, 0u, 0u, 0u}; *(v4u*)(XS + (size_t)s * D + 512 + 8 * lane) = (v4u){0u, 0u, 0u, 0u}; if (lane == 0) { RD[s] = -1; RG[s] = 0.f; } }
    }
}

__global__ void __launch_bounds__(NWAVES * 64, 2) fwd(Args args) {
    extern __shared__ __attribute__((aligned(16))) unsigned char lds_raw[];
    Frame F0;
    F0.lds = (LAS unsigned char*)lds_raw;
    F0.tid = 0; F0.lane = 0; F0.wave = 0;
    F0.G = gridDim.x; { const int bx = blockIdx.x; F0.vcu = (F0.G % 8 == 0) ? (bx % 8) * (F0.G / 8) + bx / 8 : bx; }
    F0.ws = args.ws; F0.out = args.out;
    volatile LAS unsigned* MISC = (volatile LAS unsigned*)(F0.lds + MISC_OFF);
    gu32* ctl = (gu32*)(F0.ws + WS_CTL);
    for (int u = threadIdx.x; u < (LDS_BYTES - RING_BYTES) / 4; u += NWAVES * 64) ((LAS unsigned*)(F0.lds + RING_BYTES))[u] = 0u;
    __syncthreads();
    const int lo = args.ph_lo, hi = args.ph_hi;
    const bool multi = (hi - lo) > 1;
    XcdBarrier bar; bar.bar = (unsigned*)(ctl + CW_BAR); bar.x = 0; bar.st = nullptr;
    if (multi) bar = xcd_barrier_post((unsigned*)(ctl + CW_BAR), MISC + 8);
#ifndef PHMASK
#define PHMASK 0xfff
#endif
#define IN(k) (((PHMASK >> ((k) % PH_PER_LAYER)) & 1) && lo <= (k) && (k) < hi)
#define SEAM(k) do { if (IN((k) + 1) && IN(k)) xcd_barrier(bar); } while (0)

#define PHASE_FRAME() Frame F = F0; { int t_ = threadIdx.x; asm volatile("" : "+v"(t_)); F.tid = t_; F.lane = t_ & 63; F.wave = __builtin_amdgcn_readfirstlane(t_ >> 6); }
#define LAYER_BODY(moe) do { const int P0 = l * PH_PER_LAYER; const int li = l >> 1; (void)li; \
         \
        if (IN(P0 + 0)) { PHASE_FRAME(); conv_mixer_weights(F, l); if (l == 0) conv_x(F); SEAM(P0 + 0); } \
         \
        if (IN(P0 + 1)) { PHASE_FRAME(); \
            pg8::Gemm g{(const pg8::bf16_t*)(F.ws + WS_XB), (const pg8::bf16_t*)(F.ws + WS_WIN), M, NPROJ, D}; pg8::StaticOrder S; S.init(M, NPROJ, F.G, (int)blockIdx.x); \
            pg8::EpiBf16<0> E{(pg8::bf16_t*)(F.ws + WS_PROJ), NPROJ, nullptr, 0, 0, 1.f}; \
            pg8::gemm_phase<pg8::EpiBf16<0>, pg8::StaticOrder, true, true>(F.lds, g, S, E); \
            SEAM(P0 + 1); \
        } \
         \
        if (IN(P0 + 2)) { PHASE_FRAME(); prep_phase(F, l); SEAM(P0 + 2); } \
         \
        if (IN(P0 + 3)) { PHASE_FRAME(); scan_phase(F); SEAM(P0 + 3); } \
        if (IN(P0 + 4)) { PHASE_FRAME(); attn_phase(F); SEAM(P0 + 4); } \
         \
        if (IN(P0 + 5)) { PHASE_FRAME(); post_phase(F, l); SEAM(P0 + 5); } \
         \
        if (IN(P0 + 6)) { PHASE_FRAME(); \
            pg8::Gemm g{(const pg8::bf16_t*)(F.ws + WS_MIX), (const pg8::bf16_t*)(F.ws + WS_WOUT), M, D, D}; pg8::StaticOrder S; S.init(M, D, F.G, (int)blockIdx.x); \
            pg8::EpiBf16<0> E{(pg8::bf16_t*)(F.ws + WS_Y), D, nullptr, 0, 0, 1.f}; \
            pg8::gemm_phase<pg8::EpiBf16<0>, pg8::StaticOrder, true, true>(F.lds, g, S, E); \
            __syncthreads(); \
            conv_ffn_weights(F, l); \
            SEAM(P0 + 6); \
        } \
         \
        if (IN(P0 + 7)) { PHASE_FRAME(); unsigned* cnt = (unsigned*)(F.ws + WS_CTL) + CW_MOE + 64 * li; \
            const float* gam = inp(18) + (size_t)l * D; const float* bet = inp(19) + (size_t)l * D; \
            if (moe) ln_phase<0, true, false>(F, (const bf16*)(F.ws + WS_Y), gam, bet, inp(25) + (size_t)li * D * 8, cnt); \
            else ln_phase<0, false, false>(F, (const bf16*)(F.ws + WS_Y), gam, bet, nullptr, nullptr); \
            SEAM(P0 + 7); \
        } \
         \
        if (IN(P0 + 8)) { PHASE_FRAME(); unsigned* cnt = (unsigned*)(F.ws + WS_CTL) + CW_MOE + 64 * li; if (moe) moe_build_phase(F, cnt); SEAM(P0 + 8); } \
         \
        if (IN(P0 + 9)) { PHASE_FRAME(); unsigned* cnt = (unsigned*)(F.ws + WS_CTL) + CW_MOE + 64 * li; \
            if (!moe) { \
                pg8::Gemm g{(const pg8::bf16_t*)(F.ws + WS_XB), (const pg8::bf16_t*)(F.ws + WS_WF), M, 2 * DFF, D}; pg8::StaticOrder S; S.init(M, 2 * DFF, F.G, (int)blockIdx.x); \
                EpiSwiglu E{(bf16*)(F.ws + WS_HID), DFF}; \
                pg8::gemm_phase<EpiSwiglu, pg8::StaticOrder, true, true>(F.lds, g, S, E); \
            } else { \
                pg8::Gemm g{(const pg8::bf16_t*)(F.ws + WS_XS), (const pg8::bf16_t*)(F.ws + WS_WF), MOE_ROWS, 2 * DFE, D}; GroupedOrder S; S.init(cnt, 2 * DFE / 256, F.G, (int)blockIdx.x, (unsigned)(2 * DFE * D * 2)); \
                EpiSwiglu E{(bf16*)(F.ws + WS_HID), DFE}; \
                pg8::gemm_phase<EpiSwiglu, GroupedOrder, true, true>(F.lds, g, S, E); \
            } \
            SEAM(P0 + 9); \
        } \
         \
        if (IN(P0 + 10)) { PHASE_FRAME(); unsigned* cnt = (unsigned*)(F.ws + WS_CTL) + CW_MOE + 64 * li; \
            if (!moe) { \
                pg8::Gemm g{(const pg8::bf16_t*)(F.ws + WS_HID), (const pg8::bf16_t*)(F.ws + WS_WFD), M, D, DFF}; pg8::StaticOrder S; S.init(M, D, F.G, (int)blockIdx.x); \
                pg8::EpiBf16<0> E{(pg8::bf16_t*)(F.ws + WS_Y2), D, nullptr, 0, 0, 1.f}; \
                pg8::gemm_phase<pg8::EpiBf16<0>, pg8::StaticOrder, true, true>(F.lds, g, S, E); \
            } else { \
                pg8::Gemm g{(const pg8::bf16_t*)(F.ws + WS_HID), (const pg8::bf16_t*)(F.ws + WS_WFD), MOE_ROWS, D, DFE}; GroupedOrder S; S.init(cnt, D / 256, F.G, (int)blockIdx.x, (unsigned)(D * DFE * 2)); \
                EpiMoeDown E{(bf16*)(F.ws + WS_YPAIR), (const int*)(F.ws + WS_ROWDST), (const float*)(F.ws + WS_ROWGATE)}; \
                pg8::gemm_phase<EpiMoeDown, GroupedOrder, true, true>(F.lds, g, S, E); \
            } \
            SEAM(P0 + 10); \
        } \
         \
        if (IN(P0 + 11)) { PHASE_FRAME(); \
            const float* gam = inp(20) + (size_t)l * D; const float* bet = inp(21) + (size_t)l * D; \
            if (l == DEPTH - 1) ln_phase<1, false, true>(F, (const bf16*)(F.ws + WS_YPAIR), gam, bet, nullptr, nullptr); \
            else if (moe) ln_phase<1, false, false>(F, (const bf16*)(F.ws + WS_YPAIR), gam, bet, nullptr, nullptr); \
            else ln_phase<0, false, false>(F, (const bf16*)(F.ws + WS_Y2), gam, bet, nullptr, nullptr); \
            SEAM(P0 + 11); \
        } \
    } while (0)
    for (int lp = 0; lp < DEPTH / 2; ++lp) {
        { const int l = 2 * lp; LAYER_BODY(false); }
        { const int l = 2 * lp + 1; LAYER_BODY(true); }
    }
#undef IN
#undef SEAM
}

extern "C" void kernel_launch(void* const* d_in, const int* in_sizes, int n_in, void* d_out, int out_size, void* d_ws, size_t ws_size, hipStream_t stream) {
    static int grid = 0;
    if (grid == 0) {
        if (n_in != 29 || in_sizes[0] != M * D || out_size != M * D || ws_size < WS_END) { fprintf(stderr, "kernel_launch: unexpected shapes / workspace (%d inputs, ws %zu)\n", n_in, ws_size); grid = -1; return; }
        int dev = 0, cus = 0;
        if (hipGetDevice(&dev) != hipSuccess || hipDeviceGetAttribute(&cus, hipDeviceAttributeMultiprocessorCount, dev) != hipSuccess) { grid = -1; return; }
        if (hipFuncSetAttribute((const void*)fwd, hipFuncAttributeMaxDynamicSharedMemorySize, LDS_BYTES) != hipSuccess) { grid = -1; return; }
        grid = cus;
    }
    if (grid < 0) return;
    (void)hipMemsetAsync((char*)d_ws + WS_CTL, 0, CTL_ZERO_BYTES, stream);
    Args a{};
    for (int i = 0; i < 29; ++i) a.in[i] = (const float*)d_in[i];
    a.out = (float*)d_out; a.ws = (unsigned char*)d_ws;
#ifndef ONE_LAUNCH
#define ONE_LAUNCH 0
#endif
    if (ONE_LAUNCH) { a.ph_lo = 0; a.ph_hi = N_PHASES; hipLaunchKernelGGL(fwd, dim3(grid), dim3(NWAVES * 64), LDS_BYTES, stream, a); }
    else {
        for (int ph = 0; ph < N_PHASES; ++ph) {
            const int k = ph % PH_PER_LAYER, l = ph / PH_PER_LAYER;
            if (k == 8 && (l & 1) == 0) continue;
            a.ph_lo = ph; a.ph_hi = ph + 1;
            hipLaunchKernelGGL(fwd, dim3(grid), dim3(NWAVES * 64), LDS_BYTES, stream, a);
        }
    }
}
```

```cpp
#include <hip/hip_runtime.h>
#include <cstdio>
#include <cstdint>
#include <cmath>
namespace pg8 {
#define PG8_LAS __attribute__((address_space(3)))
typedef unsigned short bf16_t;
typedef short bf16x8 __attribute__((ext_vector_type(8)));
typedef float f32x4 __attribute__((ext_vector_type(4)));
typedef unsigned u32x4 __attribute__((ext_vector_type(4)));
constexpr int BM = 256, BK = 64, HALF = 128, HTB = HALF * BK * 2  , STAGE_BYTES = 8 * HTB, NXCD = 8, WGM = 8;

__host__ __device__ __forceinline__ int lds_byte(int r, int c) { const int st = (r >> 4) * 2 + (c >> 5), rr = r & 15, cc = c & 31, ob = rr * 64 + cc * 2; return st * 1024 + (ob ^ (((ob >> 9) & 1) << 5)); }
__host__ __device__ __forceinline__ void stage_rc(int b, int& R, int& C) { const int st = b / 1024, sb = b % 1024, swz = sb ^ (((sb >> 9) & 1) << 5); R = (st >> 1) * 16 + swz / 64; C = (st & 1) * 32 + (swz % 64) / 2; }
__host__ __device__ __forceinline__ int perm32(int rho) { const int n = rho >> 4, i = rho & 15; return 8 * (i >> 2) + 4 * n + (i & 3); }

struct Unit { int pm, pn; unsigned bofs; unsigned kofs; int nt; int q; };
struct Gemm { const bf16_t* A; const bf16_t* Bt; int M, N, K; const int* rowsrc = nullptr; unsigned aoff = 0u, zoff = 0u; };

struct StaticOrder {
    int nM, nN, nwg, G, c;
    __host__ __device__ void init(int M, int N, int G_, int c_) { nM = M / BM; nN = N / BM; nwg = nM * nN; G = G_; c = c_; }
    __host__ __device__ bool next(int i, Unit& u) const {
        const long L = (long)i * G + c; if (L >= nwg) return false;
        int wgid = (int)L; { const int q = nwg / NXCD, r = nwg % NXCD, xcd = wgid % NXCD, off = wgid / NXCD; wgid = (xcd < r ? xcd * (q + 1) : r * (q + 1) + (xcd - r) * q) + off; }
        const int nig = WGM * nN, gid = wgid / nig, fm = gid * WGM, gsz = (nM - fm) < WGM ? (nM - fm) : WGM;
        u.pm = fm + ((wgid % nig) % gsz); u.pn = (wgid % nig) / gsz; u.bofs = 0u; u.kofs = 0u; u.nt = 0; u.q = 0; return true;
    }
    __device__ __forceinline__ void a_ready(const Unit&) const {}
    __device__ __forceinline__ void done(const Unit&) const {}
};

__device__ __forceinline__ unsigned cvt_pk_bf16(float lo, float hi) { unsigned r; asm volatile("v_cvt_pk_bf16_f32 %0, %1, %2" : "=v"(r) : "v"(lo), "v"(hi)); return r; }
typedef float f32x2 __attribute__((ext_vector_type(2)));
__device__ __forceinline__ f32x2 gelu_pk(f32x2 v) {
    const f32x2 av = __builtin_elementwise_abs(v), d = av * 0.2316418882f + 1.0f;
    f32x2 t; t.x = __builtin_amdgcn_rcpf(d.x); t.y = __builtin_amdgcn_rcpf(d.y);
    f32x2 q = t * 0.5307027145f + (-0.7265760135f); q = q * t + 0.7107068705f; q = q * t + (-0.142248368f); q = q * t + 0.127414796f; q = q * t;
    const f32x2 s = (v * v) * (-0.72134752044f);
    f32x2 e; e.x = __builtin_amdgcn_exp2f(s.x); e.y = __builtin_amdgcn_exp2f(s.y);
    const f32x2 m = v * (q * e), r = v - m;
    f32x2 o; o.x = v.x < 0.f ? m.x : r.x; o.y = v.y < 0.f ? m.y : r.y; return o;
}

template <int ACT  > struct EpiBf16 {
    static constexpr bool PERM = true, AFTER_DRAIN = false; static_assert(ACT == 0 || ACT == 1, "EpiBf16: ACT is 0 (none) or 1 (gelu_pk)");
    bf16_t* O; int ldc; const float* bias; int split_cols; size_t split_stride; float scale0;
    __device__ __forceinline__ void operator()(const f32x4 (&acc)[2][2][4][2], const Unit& u, int wr, int wc, int fr, int fq) const {
        const int row0 = u.pm * BM + wr * 64 + fr; int colt = u.pn * BM; bf16_t* base = O;
        float sc = 1.f; if (split_cols) { const int t = colt / split_cols; base += (size_t)t * split_stride; colt -= t * split_cols; if (t == 0) sc = scale0; }
        const int col0 = colt + wc * 32 + 8 * fq, bcol0 = u.pn * BM + wc * 32 + 8 * fq;
        f32x4 bv[2][2];
#pragma unroll
        for (int bj = 0; bj < 2; ++bj)
#pragma unroll
            for (int n = 0; n < 2; ++n) bv[bj][n] = bias ? *(const f32x4*)(bias + bcol0 + bj * HALF + 4 * n) : (f32x4){0.f, 0.f, 0.f, 0.f};
#pragma unroll
        for (int ai = 0; ai < 2; ++ai)
#pragma unroll
            for (int m = 0; m < 4; ++m) { bf16_t* rowp = base + (size_t)(row0 + ai * HALF + m * 16) * ldc + col0;
#pragma unroll
                for (int bj = 0; bj < 2; ++bj) { f32x4 v0 = acc[ai][bj][m][0] + bv[bj][0], v1 = acc[ai][bj][m][1] + bv[bj][1];
                    if (ACT == 1) { f32x2 a = gelu_pk((f32x2){v0[0], v0[1]}), b = gelu_pk((f32x2){v0[2], v0[3]}), c = gelu_pk((f32x2){v1[0], v1[1]}), d = gelu_pk((f32x2){v1[2], v1[3]});
                        v0 = (f32x4){a.x, a.y, b.x, b.y}; v1 = (f32x4){c.x, c.y, d.x, d.y}; }
                    v0 = v0 * sc; v1 = v1 * sc; u32x4 w; w.x = cvt_pk_bf16(v0[0], v0[1]); w.y = cvt_pk_bf16(v0[2], v0[3]); w.z = cvt_pk_bf16(v1[0], v1[1]); w.w = cvt_pk_bf16(v1[2], v1[3]);
                    *(u32x4*)(rowp + bj * HALF) = w; } }
    }
};

template <class Epi, class Sched, bool ALIGN_EPI = false, bool SP2 = false, bool GATHER = false>
__device__ __forceinline__ void gemm_phase(PG8_LAS unsigned char* lds, const Gemm g, const Sched& S, const Epi& E) {
    int tid_l = threadIdx.x; asm volatile("" : "+v"(tid_l));
    const int tid = tid_l, wid = __builtin_amdgcn_readfirstlane(tid >> 6), lane = tid & 63, wr = wid >> 2, wc = wid & 3, fr = lane & 15, fq = lane >> 4;
    const int K = g.K; int nt = K / BK;
    unsigned voffA[2], voffB[2]; int rowA[2]; unsigned colA[2];
#pragma unroll
    for (int i = 0; i < 2; ++i) { int R, C; stage_rc(tid * 16 + i * 8192, R, C); const int Rb = Epi::PERM ? ((R & ~31) + perm32(R & 31)) : R;
        voffA[i] = (unsigned)(R * K + C) * 2u; voffB[i] = (unsigned)(Rb * K + C) * 2u; rowA[i] = R; colA[i] = (unsigned)C * 2u; }
    unsigned gC[2][2] = {{0u, 0u}, {0u, 0u}}, gN[2][2] = {{0u, 0u}, {0u, 0u}};
#define PG8_GOFF(dst, pm_) do { _Pragma("unroll") for (int h_ = 0; h_ < 2; ++h_) _Pragma("unroll") for (int i_ = 0; i_ < 2; ++i_) { const int rs_ = g.rowsrc[(pm_) * BM + h_ * HALF + rowA[i_]]; \
        dst[h_][i_] = (rs_ >= 0 ? g.aoff + (unsigned)rs_ * (unsigned)(K * 2) : g.zoff) + colA[i_]; } } while (0)
#define PG8_STAGE_A(bufoff, ptr, h, G) do { if constexpr (GATHER) PG8_STAGE(bufoff, ptr, G[h]); else PG8_STAGE(bufoff, (ptr) + (h) * hstep, voffA); } while (0)
    const size_t kstep = (size_t)(BK * 2);
    const size_t hstep = (size_t)HALF * K * 2;
    const size_t tstep = 2 * hstep;
    const unsigned ldsw = (unsigned)wid * 1024u;
    const int aoff = lds_byte(wr * 64 + fr, fq * 8), boff = lds_byte(wc * 32 + fr, fq * 8);
#define PG8_SA(b, h) (((b) * 2 + (h)) * HTB)
#define PG8_SB(b, h) ((4 + (b) * 2 + (h)) * HTB)
#define PG8_STAGE(bufoff, gbase, voff) do { _Pragma("unroll") for (int _i = 0; _i < 2; ++_i) \
        __builtin_amdgcn_global_load_lds((const unsigned*)((const char*)(gbase) + (voff)[_i]), (PG8_LAS unsigned*)(lds + (bufoff) + ldsw + _i * 8192), 16, 0, 0); } while (0)
#define PG8_LDA(dst, b, h) do { _Pragma("unroll") for (int m = 0; m < 4; ++m) _Pragma("unroll") for (int k = 0; k < 2; ++k) dst[m][k] = *(const PG8_LAS bf16x8*)(lds + PG8_SA(b, h) + aoff + m * 2048 + k * 1024); } while (0)
#define PG8_LDB(dst, b, h) do { _Pragma("unroll") for (int n = 0; n < 2; ++n) _Pragma("unroll") for (int k = 0; k < 2; ++k) dst[n][k] = *(const PG8_LAS bf16x8*)(lds + PG8_SB(b, h) + boff + n * 2048 + k * 1024); } while (0)
#define PG8_MMA(ai, bj, At, Bt) do { __builtin_amdgcn_s_setprio(1); _Pragma("unroll") for (int m = 0; m < 4; ++m) _Pragma("unroll") for (int n = 0; n < 2; ++n) _Pragma("unroll") for (int k = 0; k < 2; ++k) \
        acc[ai][bj][m][n] = __builtin_amdgcn_mfma_f32_16x16x32_bf16(Bt[n][k], At[m][k], acc[ai][bj][m][n], 0, 0, 0); __builtin_amdgcn_s_setprio(0); } while (0)
#define PG8_WAIT_V(n) asm volatile("s_waitcnt vmcnt(" #n ")" ::: "memory")
#define PG8_WAIT_L(n) asm volatile("s_waitcnt lgkmcnt(" #n ")" ::: "memory")
#define PG8_BAR __builtin_amdgcn_s_barrier()
#define PG8_SCHED __builtin_amdgcn_sched_barrier(0)
    Unit cur, nxt; int ui = 0;
    if (!S.next(0, cur)) return;
    f32x4 acc[2][2][4][2];
#pragma unroll
    for (int a = 0; a < 2; ++a)
#pragma unroll
        for (int b = 0; b < 2; ++b)
#pragma unroll
            for (int m = 0; m < 4; ++m)
#pragma unroll
                for (int n = 0; n < 2; ++n) acc[a][b][m][n] = (f32x4){0.f, 0.f, 0.f, 0.f};
    bf16x8 At[4][2], B0[2][2], B1[2][2];
    const char* cA = (const char*)g.A + (GATHER ? (size_t)0 : (size_t)cur.pm * tstep) + cur.kofs; if constexpr (GATHER) PG8_GOFF(gC, cur.pm);
    const char* cB = (const char*)g.Bt + (size_t)cur.bofs + (size_t)cur.pn * tstep + cur.kofs; if (cur.nt) nt = cur.nt;
    S.a_ready(cur);
    if constexpr (SP2) {
        PG8_STAGE(PG8_SB(0, 0), cB, voffB); PG8_STAGE(PG8_SB(0, 1), cB + hstep, voffB); PG8_STAGE_A(PG8_SA(0, 0), cA, 0, gC); PG8_STAGE_A(PG8_SA(0, 1), cA, 1, gC);
        if (wr == 1) PG8_BAR;
        PG8_WAIT_V(2); PG8_BAR;
        PG8_STAGE(PG8_SB(1, 0), cB + kstep, voffB); PG8_STAGE_A(PG8_SA(1, 0), cA + kstep, 0, gC); PG8_STAGE(PG8_SB(1, 1), cB + hstep + kstep, voffB);
        PG8_WAIT_V(6); PG8_BAR;
    } else {
        PG8_STAGE(PG8_SB(0, 0), cB, voffB); PG8_STAGE(PG8_SA(0, 0), cA, voffA); PG8_STAGE(PG8_SB(0, 1), cB + hstep, voffB); PG8_STAGE(PG8_SA(0, 1), cA + hstep, voffA);
        if (wr == 1) PG8_BAR;
        PG8_WAIT_V(4); PG8_BAR;
        PG8_STAGE(PG8_SB(1, 0), cB + kstep, voffB); PG8_STAGE(PG8_SA(1, 0), cA + kstep, voffA); PG8_STAGE(PG8_SB(1, 1), cB + hstep + kstep, voffB);
        PG8_WAIT_V(6); PG8_BAR;
    }
    for (;;) {
        const bool has_next = S.next(ui + 1, nxt);
        const char* nA = has_next ? (const char*)g.A + (GATHER ? (size_t)0 : (size_t)nxt.pm * tstep) + nxt.kofs : cA;
        const char* nB = has_next ? (const char*)g.Bt + (size_t)nxt.bofs + (size_t)nxt.pn * tstep + nxt.kofs : cB;
        PG8_LAS unsigned char* gtbl = lds + STAGE_BYTES + 4096 + (ui & 1) * 1024;
        if constexpr (GATHER) { if (has_next && wid < 4) __builtin_amdgcn_global_load_lds((const unsigned*)(g.rowsrc + nxt.pm * BM + 64 * wid + lane), (PG8_LAS unsigned*)(gtbl + 256 * wid), 4, 0, 0); }
        for (int t = 0; t < nt; t += 2) {
            const bool last = (t == nt - 2);
            const char* a1 = cA + (size_t)(t + 1) * kstep;
            const char* a2 = last ? nA : cA + (size_t)(t + 2) * kstep; const char* b2 = last ? nB : cB + (size_t)(t + 2) * kstep;
            const char* a3 = a2 + kstep; const char* b3 = b2 + kstep;
            if (last && has_next) S.a_ready(nxt);
            unsigned g2[2][2] = {{gC[0][0], gC[0][1]}, {gC[1][0], gC[1][1]}};
            if constexpr (GATHER) { if (last && has_next) { asm volatile("" ::: "memory");
                _Pragma("unroll") for (int h_ = 0; h_ < 2; ++h_) _Pragma("unroll") for (int i_ = 0; i_ < 2; ++i_) { const int rs_ = *(const PG8_LAS int*)(gtbl + (h_ * HALF + rowA[i_]) * 4); gN[h_][i_] = (rs_ >= 0 ? g.aoff + (unsigned)rs_ * (unsigned)(K * 2) : g.zoff) + colA[i_]; g2[h_][i_] = gN[h_][i_]; } } }
            if constexpr (SP2) {
            PG8_LDB(B0, 0, 0); PG8_LDB(B1, 0, 1); PG8_SCHED; PG8_LDA(At, 0, 0); PG8_STAGE_A(PG8_SA(1, 1), a1, 1, gC);
            PG8_WAIT_V(8); PG8_WAIT_L(0); PG8_BAR; PG8_MMA(0, 0, At, B0); PG8_MMA(0, 1, At, B1); PG8_BAR; PG8_SCHED;
            PG8_LDA(At, 0, 1); PG8_STAGE(PG8_SB(0, 0), b2, voffB); PG8_STAGE(PG8_SB(0, 1), b2 + hstep, voffB); PG8_STAGE_A(PG8_SA(0, 0), a2, 0, g2);
            PG8_WAIT_V(8); PG8_WAIT_L(0); PG8_BAR; PG8_MMA(1, 0, At, B0); PG8_MMA(1, 1, At, B1); PG8_BAR; PG8_SCHED;
            PG8_LDB(B0, 1, 0); PG8_LDB(B1, 1, 1); PG8_SCHED; PG8_LDA(At, 1, 0); PG8_STAGE_A(PG8_SA(0, 1), a2, 1, g2);
            PG8_WAIT_V(8); PG8_WAIT_L(0); PG8_BAR; PG8_MMA(0, 0, At, B0); PG8_MMA(0, 1, At, B1); PG8_BAR; PG8_SCHED;
            PG8_LDA(At, 1, 1); PG8_STAGE(PG8_SB(1, 0), b3, voffB); PG8_STAGE(PG8_SB(1, 1), b3 + hstep, voffB); PG8_STAGE_A(PG8_SA(1, 0), a3, 0, g2);
            PG8_WAIT_V(8); PG8_WAIT_L(0); PG8_BAR; PG8_MMA(1, 0, At, B0); PG8_MMA(1, 1, At, B1); PG8_BAR; PG8_SCHED;
            } else {
            PG8_LDB(B0, 0, 0); PG8_SCHED; PG8_LDA(At, 0, 0); PG8_STAGE(PG8_SA(1, 1), a1 + hstep, voffA);
            PG8_WAIT_L(8); PG8_BAR; PG8_WAIT_L(0); PG8_MMA(0, 0, At, B0); PG8_BAR; PG8_SCHED;
            PG8_LDB(B1, 0, 1); PG8_STAGE(PG8_SB(0, 0), b2, voffB);
            PG8_BAR; PG8_WAIT_L(0); PG8_MMA(0, 1, At, B1); PG8_BAR;
            PG8_LDA(At, 0, 1); PG8_STAGE(PG8_SA(0, 0), a2, voffA);
            PG8_BAR; PG8_WAIT_L(0); PG8_MMA(1, 0, At, B0); PG8_BAR; PG8_SCHED;
            PG8_STAGE(PG8_SB(0, 1), b2 + hstep, voffB);
            PG8_WAIT_V(6); PG8_BAR; PG8_MMA(1, 1, At, B1); PG8_BAR;
            PG8_LDB(B0, 1, 0); PG8_SCHED; PG8_LDA(At, 1, 0); PG8_STAGE(PG8_SA(0, 1), a2 + hstep, voffA);
            PG8_WAIT_L(8); PG8_BAR; PG8_WAIT_L(0); PG8_MMA(0, 0, At, B0); PG8_BAR; PG8_SCHED;
            PG8_LDB(B1, 1, 1); PG8_STAGE(PG8_SB(1, 0), b3, voffB);
            PG8_BAR; PG8_WAIT_L(0); PG8_MMA(0, 1, At, B1); PG8_BAR;
            PG8_LDA(At, 1, 1); PG8_STAGE(PG8_SA(1, 0), a3, voffA);
            PG8_BAR; PG8_WAIT_L(0); PG8_MMA(1, 0, At, B0); PG8_BAR; PG8_SCHED;
            PG8_STAGE(PG8_SB(1, 1), b3 + hstep, voffB);
            PG8_WAIT_V(6); PG8_BAR; PG8_MMA(1, 1, At, B1); PG8_BAR;
            }
        }
        if constexpr (ALIGN_EPI) { if (wr == 0) PG8_BAR; }
        if constexpr (!Epi::AFTER_DRAIN) { E(acc, cur, wr, wc, fr, fq); S.done(cur); }
        if (!has_next) break;
#pragma unroll
        for (int a = 0; a < 2; ++a)
#pragma unroll
            for (int b = 0; b < 2; ++b)
#pragma unroll
                for (int m = 0; m < 4; ++m)
#pragma unroll
                    for (int n = 0; n < 2; ++n) acc[a][b][m][n] = (f32x4){0.f, 0.f, 0.f, 0.f};
        cur = nxt; cA = nA; cB = nB; ++ui; nt = cur.nt ? cur.nt : K / BK;
        if constexpr (GATHER) { gC[0][0] = gN[0][0]; gC[0][1] = gN[0][1]; gC[1][0] = gN[1][0]; gC[1][1] = gN[1][1]; }
        if constexpr (ALIGN_EPI) { if (wr == 1) PG8_BAR; }
    }
    PG8_WAIT_V(0);
    if constexpr (!ALIGN_EPI) { if (wr == 0) PG8_BAR; }
    PG8_BAR;
    if constexpr (Epi::AFTER_DRAIN) { E.fused(acc, cur, wr, wc, fr, fq, lds, wid, lane); S.done(cur); }
#undef PG8_SA
#undef PG8_SB
#undef PG8_STAGE
#undef PG8_STAGE_A
#undef PG8_GOFF
#undef PG8_LDA
#undef PG8_LDB
#undef PG8_MMA
#undef PG8_WAIT_V
#undef PG8_WAIT_L
#undef PG8_BAR
#undef PG8_SCHED
}
}
#define GAS __attribute__((address_space(1)))
#define LAS __attribute__((address_space(3)))
typedef unsigned short bf16;
typedef unsigned v4u __attribute__((ext_vector_type(4)));
typedef float f32x4 __attribute__((ext_vector_type(4)));
typedef short bf16x8 __attribute__((ext_vector_type(8)));
typedef GAS unsigned gu32;
typedef GAS unsigned long long gu64;
#define RLX_AGENT __ATOMIC_RELAXED, __HIP_MEMORY_SCOPE_AGENT
#define LDS_WAIT() asm volatile("s_waitcnt lgkmcnt(0)" ::: "memory")
#define VM_WAIT() asm volatile("s_waitcnt vmcnt(0)" ::: "memory")
__device__ __forceinline__ unsigned long long rt() { return __builtin_amdgcn_s_memrealtime(); }
__device__ __forceinline__ unsigned f2bf(float f) { unsigned u = __builtin_bit_cast(unsigned, f); return (u + 0x7fffu + ((u >> 16) & 1u)) >> 16; }
__device__ __forceinline__ unsigned pk2(float lo, float hi) { return f2bf(lo) | (f2bf(hi) << 16); }

#define XB_TMO      128
#define XB_XCNT(j)  (256  + 64 * (j))
#define XB_XSUB(j)  (1280 + 64 * (j))
#define XB_XGEN(j)  (2304 + 64 * (j))
#define XB_TOP      3328
#define XB_TOPGEN   3392
#define XCD_BAR_WORDS 3456
#define XB_SPIN_CAP (1u << 18)

__device__ __forceinline__ unsigned xb_ld(unsigned* p)              { return __hip_atomic_load(p, __ATOMIC_RELAXED, __HIP_MEMORY_SCOPE_AGENT); }
__device__ __forceinline__ unsigned xb_add(unsigned* p, unsigned v) { return __hip_atomic_fetch_add(p, v, __ATOMIC_RELAXED, __HIP_MEMORY_SCOPE_AGENT); }
__device__ __forceinline__ unsigned xb_xcc_id() { return (unsigned)__builtin_amdgcn_s_getreg((3 << 11) | 20) & 0xFu; }
#define XB_SPIN(cond, bar) do { unsigned _sp = 0; while (cond) { __builtin_amdgcn_s_sleep(1); \
    if ((++_sp & 255u) == 0u) { if (xb_ld(&(bar)[XB_TMO])) break; if (_sp > XB_SPIN_CAP) { atomicAdd(&(bar)[XB_TMO], 1u); break; } } } } while (0)

struct XcdBarrier {
    unsigned* bar; unsigned x;
    volatile LAS unsigned* st;
};

__device__ __forceinline__ XcdBarrier xcd_barrier_post(unsigned* bar, volatile LAS unsigned* st) {
    XcdBarrier b; b.bar = bar; b.x = xb_xcc_id(); b.st = st;
    if (threadIdx.x == 0) (void)xb_add(&bar[XB_XCNT(b.x)], 1u);
    return b;
}
__device__ __forceinline__ void xcd_barrier_complete(unsigned* bar, unsigned x, unsigned& nloc, unsigned& nx) {
    const unsigned G = gridDim.x * gridDim.y * gridDim.z;
    unsigned sum, cnt, mine, sp = 0u;
    for (;;) {
        sum = 0u; cnt = 0u; mine = 0u;
#pragma unroll
        for (unsigned j = 0; j < 16; ++j) { const unsigned c = xb_ld(&bar[XB_XCNT(j)]); sum += c; cnt += (c > 0u) ? 1u : 0u; mine = (j == x) ? c : mine; }
        if (sum == G) break;
        __builtin_amdgcn_s_sleep(1);
        if ((++sp & 255u) == 0u) { if (xb_ld(&bar[XB_TMO])) break; if (sp > XB_SPIN_CAP) { atomicAdd(&bar[XB_TMO], 1u); break; } }
    }
    nloc = mine > 0u ? mine : 1u; nx = cnt > 0u ? cnt : 1u;
}

__device__ __forceinline__ void xcd_barrier(const XcdBarrier& b) {
    asm volatile("s_waitcnt vmcnt(0)" ::: "memory");
    __syncthreads();
    if (threadIdx.x == 0) {
        unsigned* bar = b.bar;
        __builtin_amdgcn_s_waitcnt(0);
        unsigned nloc = b.st[0], nx = b.st[1];
        if (nloc == 0u) { xcd_barrier_complete(bar, b.x, nloc, nx); b.st[0] = nloc; b.st[1] = nx; }
        const unsigned old = xb_add(&bar[XB_XSUB(b.x)], 1u);
        const unsigned gen = old / nloc;
        if (old + 1u == (gen + 1u) * nloc) {
            __builtin_amdgcn_fence(__ATOMIC_RELEASE, "agent");
            asm volatile("s_waitcnt vmcnt(0)" ::: "memory");
            const unsigned og = xb_add(&bar[XB_TOP], 1u);
            const unsigned tg = og / nx;
            if (og + 1u == (tg + 1u) * nx) xb_add(&bar[XB_TOPGEN], 1u);
            else XB_SPIN(xb_ld(&bar[XB_TOPGEN]) == tg, bar);
            __builtin_amdgcn_fence(__ATOMIC_ACQUIRE, "agent");
            xb_add(&bar[XB_XGEN(b.x)], 1u);
            asm volatile("s_waitcnt vmcnt(0)" ::: "memory");
        } else {
            XB_SPIN(xb_ld(&bar[XB_XGEN(b.x)]) == gen, bar);
            __builtin_amdgcn_fence(__ATOMIC_ACQUIRE, "agent");
            asm volatile("s_waitcnt vmcnt(0)" ::: "memory");
        }
    }
    __syncthreads();
}

constexpr int NWAVES = 8;
constexpr int BATCH = 8, SEQ = 4096, M = BATCH * SEQ, D = 1024, DEPTH = 4;
constexpr int NPROJ = 3584;
constexpr int HW = 512;
constexpr int DFF = 2816, DFE = 3584, NEXP = 8;
constexpr int MOE_ROWS = 2 * M + NEXP * 256;
constexpr float DN_ALPHA = 1.681792830507429f;
constexpr float LN_EPS = 1e-5f, GN_EPS = 64e-5f;
constexpr int PH_PER_LAYER = 12, N_PHASES = DEPTH * PH_PER_LAYER;

constexpr size_t MiB = 1u << 20;
constexpr size_t WS_CTL = 0, CTL_ZERO_BYTES = 1 * MiB, WS_ZROW = 768 * 1024;
constexpr size_t WS_WIN = 2 * MiB, WS_WOUT = 9 * MiB, WS_WLORA = 11 * MiB;
constexpr size_t WS_WF = 12 * MiB, WS_WFD = WS_WF + 112 * MiB;
constexpr size_t WS_XB = 180 * MiB, WS_VF = 244 * MiB, WS_BIG = 276 * MiB;
constexpr size_t WS_PROJ = WS_BIG, WS_SCANIN = WS_BIG + 224 * MiB, WS_BONUS = WS_BIG + 480 * MiB, WS_G = WS_BIG + 608 * MiB;
constexpr size_t WS_YS = WS_BIG + 512 * MiB;
constexpr size_t WS_MIX = WS_SCANIN, WS_Y = WS_SCANIN + 64 * MiB;
constexpr int OP_OFF = 3072, LSE_OFF = 6144, PROW = NPROJ * 2;
constexpr size_t WS_HID = WS_BIG, WS_XS = WS_BIG + 464 * MiB, WS_YPAIR = WS_XS, WS_Y2 = WS_XS;
constexpr size_t WS_ROWSRC = WS_BIG + 630 * MiB, WS_ROWDST = WS_BIG + 600 * MiB, WS_ROWGATE = WS_BIG + 601 * MiB, WS_CHOICE = WS_BIG + 602 * MiB;
constexpr size_t WS_CNTB = WS_BIG + 603 * MiB;
constexpr size_t WS_PT = WS_BIG + 604 * MiB;
constexpr int PT_TILES = 8;
constexpr size_t WS_END = WS_BIG + 640 * MiB;
static_assert(WS_XS + (size_t)MOE_ROWS * D * 2 <= WS_ROWDST && WS_HID + (size_t)MOE_ROWS * DFE * 2 <= WS_XS, "ws map");
static_assert(WS_SCANIN + (size_t)M * 8 * 1024 <= WS_BONUS && WS_YS + (size_t)M * HW * 4 <= WS_ROWDST, "ws map");
constexpr int CW_BAR = 4096;
constexpr int CW_MOE = 512;

constexpr int LDS_BYTES = 147456, RING_BYTES = 131072, MISC_OFF = RING_BYTES + 320;

#ifndef PROBE_DUP
#define PROBE_DUP 0
#endif
#ifndef DBG_SYNC_CONV
#define DBG_SYNC_CONV 0
#endif
#ifndef DBG_RECONV
#define DBG_RECONV 0
#endif
struct Args { const float* in[29]; float* out; unsigned char* ws; int ph_lo, ph_hi; };

__device__ __forceinline__ float bf2f(unsigned short h) { return __builtin_bit_cast(float, (unsigned)h << 16); }
__device__ __forceinline__ float u2f(unsigned u) { return __builtin_bit_cast(float, u); }
__device__ __forceinline__ float bflo(unsigned w) { return __builtin_bit_cast(float, w << 16); }
__device__ __forceinline__ float bfhi(unsigned w) { return __builtin_bit_cast(float, w & 0xffff0000u); }
typedef float f32x2_t __attribute__((ext_vector_type(2))); typedef __bf16 bf16x2_t __attribute__((ext_vector_type(2)));
__device__ __forceinline__ unsigned cvtpk(float lo, float hi) { const f32x2_t v = {lo, hi}; const bf16x2_t b = __builtin_convertvector(v, bf16x2_t); return __builtin_bit_cast(unsigned, b); }
typedef unsigned u32x2 __attribute__((ext_vector_type(2)));
template <int CTRL> __device__ __forceinline__ float dppf(float x) { return __builtin_bit_cast(float, __builtin_amdgcn_update_dpp(0, __builtin_bit_cast(int, x), CTRL, 0xf, 0xf, false)); }
__device__ __forceinline__ float red4(float x) { x += dppf<0xB1>(x); x += dppf<0x4E>(x); return x; }
__device__ __forceinline__ float red8(float x) { x = red4(x); x += dppf<0x141>(x); return x; }
__device__ __forceinline__ float red16(float x) { x = red8(x); x += dppf<0x140>(x); return x; }
__device__ __forceinline__ float wave_sum(float v) {
#pragma unroll
    for (int o = 1; o < 64; o <<= 1) v += __shfl_xor(v, o);
    return v;
}
__device__ __forceinline__ float fast_exp(float x) { return __builtin_amdgcn_exp2f(x * 1.4426950408889634f); }
__device__ __forceinline__ float fast_sigmoid(float x) { return __builtin_amdgcn_rcpf(1.0f + fast_exp(-x)); }
__device__ __forceinline__ float fast_tanh(float x) { const float e = fast_exp(-2.0f * fabsf(x)); const float t = (1.0f - e) * __builtin_amdgcn_rcpf(1.0f + e); return x < 0.f ? -t : t; }

__device__ __forceinline__ const float* inp(int k) {
    typedef const volatile unsigned long long __attribute__((address_space(4))) * kp_t;
    const unsigned long long v = *(kp_t)((const char __attribute__((address_space(4)))*)__builtin_amdgcn_kernarg_segment_ptr() + 8 * k);
    const unsigned lo = __builtin_amdgcn_readfirstlane((unsigned)v), hi = __builtin_amdgcn_readfirstlane((unsigned)(v >> 32));
    return (const float*)(((unsigned long long)hi << 32) | lo);
}
struct Frame {
    LAS unsigned char* lds;
    int tid, lane, wave, vcu, G;
    unsigned char* ws;
    float* out;
};

__device__ __forceinline__ void conv_item(const float* W, int K, int N, int k0, int n0, bf16* WT, int ldk, int orow0, float scale, LAS float* scr, int lane) {
#pragma unroll 8
    for (int i = 0; i < 32; ++i) { const int kk = 2 * i + (lane >> 5); if (k0 + kk < K) scr[kk * 33 + (lane & 31)] = W[(size_t)(k0 + kk) * N + n0 + (lane & 31)] * scale; }
    LDS_WAIT(); asm volatile("" ::: "memory");
    const int c = lane & 7;
    if (k0 + 8 * c < K) {
#pragma unroll
        for (int j = 0; j < 4; ++j) { const int n = (lane >> 3) + 8 * j; const LAS float* s = scr + (8 * c) * 33 + n;
            v4u o; o.x = cvtpk(s[0 * 33], s[1 * 33]); o.y = cvtpk(s[2 * 33], s[3 * 33]); o.z = cvtpk(s[4 * 33], s[5 * 33]); o.w = cvtpk(s[6 * 33], s[7 * 33]);
            *(GAS v4u*)(WT + (size_t)(orow0 + n) * ldk + k0 + 8 * c) = o; }
    }
    LDS_WAIT(); asm volatile("" ::: "memory");
}
__device__ __forceinline__ void conv_item64(const float* W, int N, int k0, int n0, bf16* WT, int ldk, int orow0, float scale, LAS unsigned char* scr, int lane) {
    const int q = lane >> 4, c4 = 4 * (lane & 15);
    f32x4 v[16];
#pragma unroll
    for (int i = 0; i < 8; ++i) { const float* p = W + (size_t)(k0 + 8 * i + 2 * q) * N + n0 + c4; v[2 * i] = *(const GAS f32x4*)p; v[2 * i + 1] = *(const GAS f32x4*)(p + N); }
#pragma unroll
    for (int i = 0; i < 8; ++i) { const f32x4 a = v[2 * i] * scale, b2 = v[2 * i + 1] * scale; LAS unsigned char* d = scr + (8 * i + 2 * q) * 2;
#pragma unroll
        for (int c = 0; c < 4; ++c) *(LAS unsigned*)(d + (c4 + c) * 144) = cvtpk(a[c], b2[c]); }
    LDS_WAIT(); asm volatile("" ::: "memory");
    const int ch = lane & 7;
#pragma unroll
    for (int j = 0; j < 8; ++j) { const int n = (lane >> 3) + 8 * j; const v4u o = *(const LAS v4u*)(scr + n * 144 + 16 * ch);
        *(GAS v4u*)(WT + (size_t)(orow0 + n) * ldk + k0 + 8 * ch) = o; }
    LDS_WAIT(); asm volatile("" ::: "memory");
}
struct ConvItem { const float* W; bf16* WT; int N, k0, n0, ldk, orow0; bool ok; float scale = 1.0f; };
__device__ __forceinline__ void conv_item64_load(const ConvItem& c, int lane, v4u (&v)[16]) {
    const int q = lane >> 4, c4 = 4 * (lane & 15);
#pragma unroll
    for (int i = 0; i < 8; ++i) { const float* p = c.W + (size_t)(c.k0 + 8 * i + 2 * q) * c.N + c.n0 + c4; v[2 * i] = *(const GAS v4u*)p; v[2 * i + 1] = *(const GAS v4u*)(p + c.N); }
}
__device__ __forceinline__ void conv_item64_finish(const ConvItem& c, int lane, const v4u (&v)[16], LAS unsigned char* scr) {
    const int q = lane >> 4, c4 = 4 * (lane & 15);
#pragma unroll
    for (int i = 0; i < 8; ++i) { LAS unsigned char* d = scr + (8 * i + 2 * q) * 2; const v4u a = v[2 * i], b2 = v[2 * i + 1];
        *(LAS unsigned*)(d + (c4 + 0) * 144) = cvtpk(u2f(a.x), u2f(b2.x));
        *(LAS unsigned*)(d + (c4 + 1) * 144) = cvtpk(u2f(a.y), u2f(b2.y));
        *(LAS unsigned*)(d + (c4 + 2) * 144) = cvtpk(u2f(a.z), u2f(b2.z));
        *(LAS unsigned*)(d + (c4 + 3) * 144) = cvtpk(u2f(a.w), u2f(b2.w)); }
    LDS_WAIT(); asm volatile("" ::: "memory");
    const int ch = lane & 7;
#pragma unroll
    for (int j = 0; j < 8; ++j) { const int n = (lane >> 3) + 8 * j; const v4u o = *(const LAS v4u*)(scr + n * 144 + 16 * ch);
        *(GAS v4u*)(c.WT + (size_t)(c.orow0 + n) * c.ldk + c.k0 + 8 * ch) = o; }
    LDS_WAIT(); asm volatile("" ::: "memory");
}
__device__ __forceinline__ ConvItem ffn_item(int l, int idx) {
    ConvItem c; const int i = l >> 1; const bool moe = (l & 1) != 0;
    const int dff = moe ? DFE : DFF, nb_gu = dff / 64, it_gu = (D / 64) * nb_gu, it_dn = (dff / 64) * (D / 64), per = 2 * it_gu + it_dn;
    const int e = idx / per, r = idx - e * per; c.ok = moe ? (e < NEXP) : (e < 1);
    const int ee = c.ok ? e : 0;
    bf16* WGU = (bf16*)0; (void)WGU;
    if (r < 2 * it_gu) { const int half = r >= it_gu, it = r - half * it_gu, kb = it / nb_gu, nb = it - kb * nb_gu, n0 = 64 * nb;
        c.W = (moe ? inp(half ? 27 : 26) : inp(half ? 23 : 22)) + ((size_t)i * (moe ? NEXP : 1) + ee) * D * dff; c.N = dff; c.k0 = 64 * kb; c.n0 = n0; c.ldk = D;
        c.orow0 = 256 * (n0 >> 7) + (n0 & 127) + 128 * half; c.WT = (bf16*)(size_t)(WS_WF + (size_t)ee * 2 * dff * D * 2); }
    else { const int it = r - 2 * it_gu, kb = it / (D / 64), nb = it - kb * (D / 64);
        c.W = (moe ? inp(28) : inp(24)) + ((size_t)i * (moe ? NEXP : 1) + ee) * dff * D; c.N = D; c.k0 = 64 * kb; c.n0 = 64 * nb; c.ldk = dff; c.orow0 = 64 * nb;
        c.WT = (bf16*)(size_t)(WS_WFD + (size_t)ee * D * dff * 2); }
    return c;
}
__device__ __forceinline__ void conv_item32_load(const ConvItem& c, int lane, v4u (&v)[16]) {
    const int q = lane >> 4, c4 = 4 * (lane & 15);
#pragma unroll
    for (int i = 0; i < 4; ++i) { const float* p = c.W + (size_t)(c.k0 + 8 * i + 2 * q) * c.N + c.n0 + c4; v[8 + 2 * i] = *(const GAS v4u*)p; v[8 + 2 * i + 1] = *(const GAS v4u*)(p + c.N); }
}
__device__ __forceinline__ void conv_item32_finish(const ConvItem& c, int lane, const v4u (&v)[16], LAS unsigned char* scr) {
    const int q = lane >> 4, c4 = 4 * (lane & 15);
#pragma unroll
    for (int i = 0; i < 4; ++i) { LAS unsigned char* d = scr + (8 * i + 2 * q) * 2; const v4u a = v[8 + 2 * i], b2 = v[8 + 2 * i + 1];
        *(LAS unsigned*)(d + (c4 + 0) * 80) = cvtpk(u2f(a.x) * c.scale, u2f(b2.x) * c.scale);
        *(LAS unsigned*)(d + (c4 + 1) * 80) = cvtpk(u2f(a.y) * c.scale, u2f(b2.y) * c.scale);
        *(LAS unsigned*)(d + (c4 + 2) * 80) = cvtpk(u2f(a.z) * c.scale, u2f(b2.z) * c.scale);
        *(LAS unsigned*)(d + (c4 + 3) * 80) = cvtpk(u2f(a.w) * c.scale, u2f(b2.w) * c.scale); }
    LDS_WAIT(); asm volatile("" ::: "memory");
    const int ch = lane & 3;
#pragma unroll
    for (int j = 0; j < 4; ++j) { const int n = (lane >> 2) + 16 * j; const v4u o = *(const LAS v4u*)(scr + n * 80 + 16 * ch);
        *(GAS v4u*)(c.WT + (size_t)(c.orow0 + n) * c.ldk + c.k0 + 8 * ch) = o; }
    LDS_WAIT(); asm volatile("" ::: "memory");
}
__device__ __forceinline__ ConvItem ffn_item32(int l, int idx) {
    ConvItem c; const int i = l >> 1; const bool moe = (l & 1) != 0;
    const int dff = moe ? DFE : DFF, nb_gu = dff / 64, it_gu = (D / 32) * nb_gu, it_dn = (dff / 32) * (D / 64), per = 2 * it_gu + it_dn;
    const int e = idx / per, r = idx - e * per; c.ok = moe ? (e < NEXP) : (e < 1);
    const int ee = c.ok ? e : 0;
    if (r < 2 * it_gu) { const int half = r >= it_gu, it = r - half * it_gu, kb = it / nb_gu, nb = it - kb * nb_gu, n0 = 64 * nb;
        c.W = (moe ? inp(half ? 27 : 26) : inp(half ? 23 : 22)) + ((size_t)i * (moe ? NEXP : 1) + ee) * D * dff; c.N = dff; c.k0 = 32 * kb; c.n0 = n0; c.ldk = D;
        c.orow0 = 256 * (n0 >> 7) + (n0 & 127) + 128 * half; c.WT = (bf16*)(size_t)(WS_WF + (size_t)ee * 2 * dff * D * 2); }
    else { const int it = r - 2 * it_gu, kb = it / (D / 64), nb = it - kb * (D / 64);
        c.W = (moe ? inp(28) : inp(24)) + ((size_t)i * (moe ? NEXP : 1) + ee) * dff * D; c.N = D; c.k0 = 32 * kb; c.n0 = 64 * nb; c.ldk = dff; c.orow0 = 64 * nb;
        c.WT = (bf16*)(size_t)(WS_WFD + (size_t)ee * D * dff * 2); }
    return c;
}
__device__ __forceinline__ ConvItem scan_item32(int l, int idx) {
    ConvItem c = ffn_item32(l, idx);
    if (c.ok || l + 1 >= DEPTH) return c;
    const bool moe = (l & 1) != 0; const int dff = moe ? DFE : DFF; const int per = 2 * (D / 32) * (dff / 64) + (dff / 32) * (D / 64);
    int r = idx - (moe ? NEXP : 1) * per; const int L = l + 1;
    c.ok = true; c.scale = 1.0f; c.N = HW;
    if (r < 32 * 52) { const int kb = r / 52, nb = r - kb * 52; c.W = inp(1) + (size_t)L * D * 3328; c.N = 3328; c.k0 = 32 * kb; c.n0 = 64 * nb; c.ldk = D; c.orow0 = c.n0; c.WT = (bf16*)(size_t)WS_WIN; c.scale = (c.n0 < 512) ? 0.125f : 1.0f; return c; }
    r -= 32 * 52;
    if (r < 16) { c.W = inp(5) + (size_t)L * 64 * HW; c.k0 = 32 * (r >> 3); c.n0 = 64 * (r & 7); c.ldk = 64; c.orow0 = c.n0; c.WT = (bf16*)(size_t)WS_WLORA; return c; }
    r -= 16;
    if (r < 16) { c.W = inp(7) + (size_t)L * 64 * HW; c.k0 = 32 * (r >> 3); c.n0 = 64 * (r & 7); c.ldk = 64; c.orow0 = c.n0; c.WT = (bf16*)(size_t)(WS_WLORA + (size_t)512 * 64 * 2); return c; }
    r -= 16;
    if (r < 32) { c.W = inp(11) + (size_t)L * 128 * HW; c.k0 = 32 * (r >> 3); c.n0 = 64 * (r & 7); c.ldk = 128; c.orow0 = c.n0; c.WT = (bf16*)(size_t)(WS_WLORA + (size_t)2 * 512 * 64 * 2); return c; }
    r -= 32;
    if (r < 8) { c.W = inp(9) + (size_t)(L - 1) * 32 * HW; c.k0 = 0; c.n0 = 64 * r; c.ldk = 32; c.orow0 = c.n0; c.WT = (bf16*)(size_t)(WS_WLORA + ((size_t)2 * 512 * 64 + 512 * 128) * 2); return c; }
    c.ok = false; return c;
}
__device__ __forceinline__ void conv_matrix(Frame& F, const float* W, int K, int N, bf16* WT, int ldk, int row_off, int mode_half, float scale_cols_lt, float scale) {
    const int gw = F.vcu * NWAVES + F.wave, NGW = F.G * NWAVES;
    if ((K & 63) == 0 && (N & 63) == 0) {
        LAS unsigned char* scr = F.lds + F.wave * 16384;
        const int nnb = N / 64, nit = (K / 64) * nnb;
        for (int it = gw; it < nit; it += NGW) {
            const int kb = it / nnb, nb = it % nnb, n0 = 64 * nb;
            int orow0; if (mode_half < 0) orow0 = row_off + n0; else orow0 = row_off + 256 * (n0 >> 7) + (n0 & 127) + 128 * mode_half;
            const float sc = ((float)n0 < scale_cols_lt) ? scale : 1.0f;
            conv_item64(W, N, 64 * kb, n0, WT, ldk, orow0, sc, scr, F.lane);
        }
    } else {
        LAS float* scr = (LAS float*)(F.lds + F.wave * 16384);
        const int nkb = (K + 63) / 64, nnb = N / 32, nit = nkb * nnb;
        for (int it = gw; it < nit; it += NGW) {
            const int kb = it / nnb, nb = it % nnb, n0 = 32 * nb;
            int orow0; if (mode_half < 0) orow0 = row_off + n0; else orow0 = row_off + 256 * (n0 >> 7) + (n0 & 127) + 128 * mode_half;
            const float sc = ((float)n0 < scale_cols_lt) ? scale : 1.0f;
            conv_item(W, K, N, 64 * kb, n0, WT, ldk, orow0, sc, scr, F.lane);
        }
    }
}
__device__ __forceinline__ void conv_mixer_rest(Frame& F, int l) {
    bf16* WIN = (bf16*)(F.ws + WS_WIN); bf16* WOUT = (bf16*)(F.ws + WS_WOUT);
    conv_matrix(F, inp(2) + (size_t)(l - 1) * D * 32, D, 32, WIN, D, 3328, -1, 0.f, 1.f);
    { const int r0 = 3360; const size_t n16 = (size_t)(NPROJ - r0) * D * 2 / 16; GAS v4u* z = (GAS v4u*)(WIN + (size_t)r0 * D);
      for (size_t i = (size_t)F.vcu * 512 + F.tid; i < n16; i += (size_t)F.G * 512) z[i] = (v4u){0u, 0u, 0u, 0u}; }
    conv_matrix(F, inp(17) + (size_t)l * D * D, D, D, WOUT, D, 0, -1, 0.f, 1.f);
}
__device__ __forceinline__ void conv_mixer_weights(Frame& F, int l) {
    bf16* WIN = (bf16*)(F.ws + WS_WIN); bf16* WOUT = (bf16*)(F.ws + WS_WOUT); bf16* WL = (bf16*)(F.ws + WS_WLORA);
    conv_matrix(F, inp(1) + (size_t)l * D * 3328, D, 3328, WIN, D, 0, -1, 512.f, 0.125f);
    if (l > 0) conv_matrix(F, inp(2) + (size_t)(l - 1) * D * 32, D, 32, WIN, D, 3328, -1, 0.f, 1.f);
    { const int r0 = (l > 0) ? 3360 : 3328; const size_t n16 = (size_t)(NPROJ - r0) * D * 2 / 16; GAS v4u* z = (GAS v4u*)(WIN + (size_t)r0 * D);
      for (size_t i = (size_t)F.vcu * 512 + F.tid; i < n16; i += (size_t)F.G * 512) z[i] = (v4u){0u, 0u, 0u, 0u}; }
    conv_matrix(F, inp(17) + (size_t)l * D * D, D, D, WOUT, D, 0, -1, 0.f, 1.f);
    conv_matrix(F, inp(5) + (size_t)l * 64 * HW, 64, HW, WL, 64, 0, -1, 0.f, 1.f);
    conv_matrix(F, inp(7) + (size_t)l * 64 * HW, 64, HW, WL + 512 * 64, 64, 0, -1, 0.f, 1.f);
    conv_matrix(F, inp(11) + (size_t)l * 128 * HW, 128, HW, WL + 2 * 512 * 64, 128, 0, -1, 0.f, 1.f);
    if (l > 0) conv_matrix(F, inp(9) + (size_t)(l - 1) * 32 * HW, 32, HW, WL + 2 * 512 * 64 + 512 * 128, 32, 0, -1, 0.f, 1.f);
}
__device__ __forceinline__ void conv_ffn_weights(Frame& F, int l) {
    bf16* WGU = (bf16*)(F.ws + WS_WF); bf16* WD = (bf16*)(F.ws + WS_WFD); const int i = l >> 1;
    if ((l & 1) == 0) {
        conv_matrix(F, inp(22) + (size_t)i * D * DFF, D, DFF, WGU, D, 0, 0, 0.f, 1.f);
        conv_matrix(F, inp(23) + (size_t)i * D * DFF, D, DFF, WGU, D, 0, 1, 0.f, 1.f);
        conv_matrix(F, inp(24) + (size_t)i * DFF * D, DFF, D, WD, DFF, 0, -1, 0.f, 1.f);
    } else {
        for (int e = 0; e < NEXP; ++e) {
            conv_matrix(F, inp(26) + ((size_t)i * NEXP + e) * D * DFE, D, DFE, WGU + (size_t)e * 2 * DFE * D, D, 0, 0, 0.f, 1.f);
            conv_matrix(F, inp(27) + ((size_t)i * NEXP + e) * D * DFE, D, DFE, WGU + (size_t)e * 2 * DFE * D, D, 0, 1, 0.f, 1.f);
            conv_matrix(F, inp(28) + ((size_t)i * NEXP + e) * DFE * D, DFE, D, WD + (size_t)e * D * DFE, DFE, 0, -1, 0.f, 1.f);
        }
    }
}
__device__ __forceinline__ void conv_x(Frame& F) {
    const GAS f32x4* x = (const GAS f32x4*)inp(0); GAS u32x2* o = (GAS u32x2*)(F.ws + WS_XB);
    for (size_t i = (size_t)F.vcu * 512 + F.tid; i < (size_t)M * D / 4; i += (size_t)F.G * 512) { const f32x4 v = x[i]; u32x2 w; w.x = cvtpk(v.x, v.y); w.y = cvtpk(v.z, v.w); o[i] = w; }
}

struct EpiSwiglu {
    static constexpr bool PERM = true, AFTER_DRAIN = false;
    bf16* O; int ldc;
    __device__ __forceinline__ void operator()(const pg8::f32x4 (&acc)[2][2][4][2], const pg8::Unit& u, int wr, int wc, int fr, int fq) const {
        const int row0 = u.pm * 256 + wr * 64 + fr, col0 = u.pn * 128 + wc * 32 + 8 * fq;
#pragma unroll
        for (int ai = 0; ai < 2; ++ai)
#pragma unroll
            for (int m = 0; m < 4; ++m) {
                bf16* rowp = O + (size_t)(row0 + ai * 128 + m * 16) * ldc + col0; float h[8];
#pragma unroll
                for (int n = 0; n < 2; ++n)
#pragma unroll
                    for (int i = 0; i < 4; ++i) { const float gt = acc[ai][0][m][n][i], up = acc[ai][1][m][n][i]; h[4 * n + i] = gt * fast_sigmoid(gt) * up; }
                v4u w; w.x = cvtpk(h[0], h[1]); w.y = cvtpk(h[2], h[3]); w.z = cvtpk(h[4], h[5]); w.w = cvtpk(h[6], h[7]);
                *(v4u*)rowp = w;
            }
    }
};
struct EpiMoeDown {
    static constexpr bool PERM = true, AFTER_DRAIN = false;
    bf16* O; const int* rowdst; const float* rowgate; float* PT; int slot0;
    __device__ __forceinline__ void operator()(const pg8::f32x4 (&acc)[2][2][4][2], const pg8::Unit& u, int wr, int wc, int fr, int fq) const {
        const int row0 = u.pm * 256 + wr * 64 + fr, col0 = u.pn * 256 + wc * 32 + 8 * fq;
        if (u.q > 0) {
            float* pb = PT + (size_t)(u.q - 1) * PT_TILES * 256 * D;
#pragma unroll
            for (int ai = 0; ai < 2; ++ai)
#pragma unroll
                for (int m = 0; m < 4; ++m) { const int slot = row0 + ai * 128 + m * 16; const float gt = rowgate[slot]; float* rp = pb + (size_t)(slot - slot0) * D + col0;
#pragma unroll
                    for (int bj = 0; bj < 2; ++bj) { *(pg8::f32x4*)(rp + bj * 128) = acc[ai][bj][m][0] * gt; *(pg8::f32x4*)(rp + bj * 128 + 4) = acc[ai][bj][m][1] * gt; } }
            return;
        }
#pragma unroll
        for (int ai = 0; ai < 2; ++ai)
#pragma unroll
            for (int m = 0; m < 4; ++m) {
                const int slot = row0 + ai * 128 + m * 16; const int dst = rowdst[slot]; const float gt = rowgate[slot];
                if (dst >= 0) { bf16* rowp = O + (size_t)dst * D + col0;
#pragma unroll
                    for (int bj = 0; bj < 2; ++bj) { const pg8::f32x4 v0 = acc[ai][bj][m][0] * gt, v1 = acc[ai][bj][m][1] * gt;
                        v4u w; w.x = cvtpk(v0[0], v0[1]); w.y = cvtpk(v0[2], v0[3]); w.z = cvtpk(v1[0], v1[1]); w.w = cvtpk(v1[2], v1[3]);
                        *(v4u*)(rowp + bj * 128) = w; } }
            }
    }
};
struct NaiveOrder {
    int nN, G, c, nwg;
    __device__ __forceinline__ void init(int M_, int N_, int G_, int c_) { nN = N_ / 256; nwg = (M_ / 256) * nN; G = G_; c = c_; }
    __device__ __forceinline__ bool next(int i, pg8::Unit& u) const { const long L = (long)i * G + c; if (L >= nwg) return false; u.pm = (int)(L / nN); u.pn = (int)(L % nN); u.bofs = 0u; u.kofs = 0u; u.nt = 0; u.q = 0; return true; }
    __device__ __forceinline__ void a_ready(const pg8::Unit&) const {}
    __device__ __forceinline__ void done(const pg8::Unit&) const {}
};
struct TailPlan { int nMt, Rfull, T, S, pm0; };
__device__ __forceinline__ TailPlan tail_plan(const unsigned* cnt, int nN, int G, bool split) {
    TailPlan p; int t = 0;
#pragma unroll
    for (int e = 0; e < 8; ++e) t += __builtin_amdgcn_readfirstlane((int)((cnt[e] + 255u) >> 8));
    p.nMt = t; const int U = t * nN; p.Rfull = U / G; p.T = U - p.Rfull * G; p.pm0 = (p.Rfull * G) / nN;
    p.S = 1; if (split && p.T > 0 && p.T <= 4 * PT_TILES && ((p.Rfull * G) % nN) == 0) p.S = (p.T * 4 <= G) ? 4 : ((p.T * 2 <= G) ? 2 : 1);
    return p;
}
struct GroupedOrder {
    int nN, G, c, nMt; int t1, t2, t3, t4, t5, t6, t7; unsigned estride; int Rfull, T, S, ntfull;
    __device__ __forceinline__ void init(const unsigned* cnt, int nN_, int G_, int c_, unsigned estride_, bool split = false, int K = 0) {
        nN = nN_; G = G_; c = c_; estride = estride_;
#define RFL(x) __builtin_amdgcn_readfirstlane((int)(x))
        int t = 0; t += RFL((cnt[0] + 255u) >> 8); t1 = t; t += RFL((cnt[1] + 255u) >> 8); t2 = t; t += RFL((cnt[2] + 255u) >> 8); t3 = t; t += RFL((cnt[3] + 255u) >> 8); t4 = t;
        t += RFL((cnt[4] + 255u) >> 8); t5 = t; t += RFL((cnt[5] + 255u) >> 8); t6 = t; t += RFL((cnt[6] + 255u) >> 8); t7 = t; t += RFL((cnt[7] + 255u) >> 8); nMt = t;
        const TailPlan p = tail_plan(cnt, nN, G, split); Rfull = p.Rfull; T = p.T; S = p.S; ntfull = K / 64;
    }
    __device__ __forceinline__ bool next(int i, pg8::Unit& u) const {
        int Lu; u.kofs = 0u; u.nt = 0; u.q = 0;
        if (S == 1) { const long L = (long)i * G + c; if (L >= (long)nMt * nN) return false; Lu = (int)L; }
        else { if (i < Rfull) Lu = i * G + c; else if (i == Rfull) { if (c >= T * S) return false; Lu = Rfull * G + c / S; const int q = c % S; u.q = q; u.nt = ntfull / S; u.kofs = (unsigned)(q * (ntfull / S) * 128); } else return false; }
        const int pm = Lu / nN, pn = Lu % nN;
        const int e = (pm >= t1) + (pm >= t2) + (pm >= t3) + (pm >= t4) + (pm >= t5) + (pm >= t6) + (pm >= t7);
        u.pm = pm; u.pn = pn; u.bofs = (unsigned)e * estride; return true;
    }
    __device__ __forceinline__ void a_ready(const pg8::Unit&) const {}
    __device__ __forceinline__ void done(const pg8::Unit&) const {}
};

constexpr int PR_ROWB = 3648, PR_PIECES = 17 * (PR_ROWB / 16), PR_BUF = 62464, PR_DUMMY = 2 * PR_BUF, PR_AOP = 132096;
__device__ __forceinline__ v4u prep_aop(const LAS unsigned char* buf, int c, int g, bool first, int kb, const float* mu, const float* muv) {
    const LAS unsigned char* pc = buf + (c + 1) * 3648 + 3072 + 16 * g + 64 * kb;
    const v4u cu = *(const LAS v4u*)(pc); v4u pv = *(const LAS v4u*)(pc - 3648); if (first) pv = (v4u){0u, 0u, 0u, 0u};
    const float* mp = (kb < 8) ? (mu + 1536 + 32 * kb + 8 * g) : (muv + 8 * g);
    const f32x4 m0v = *(const f32x4*)mp, m1v = *(const f32x4*)(mp + 4);
    float v[8] = {bflo(cu.x), bfhi(cu.x), bflo(cu.y), bfhi(cu.y), bflo(cu.z), bfhi(cu.z), bflo(cu.w), bfhi(cu.w)};
    const float p[8] = {bflo(pv.x), bfhi(pv.x), bflo(pv.y), bfhi(pv.y), bflo(pv.z), bfhi(pv.z), bflo(pv.w), bfhi(pv.w)};
#pragma unroll
    for (int j = 0; j < 8; ++j) { const float mm = (j < 4) ? m0v[j & 3] : m1v[j & 3]; v[j] = v[j] + (p[j] - v[j]) * mm; }
    if (kb < 2) {
#pragma unroll
        for (int j = 0; j < 8; ++j) v[j] = fast_tanh(v[j]);
    } else if (kb >= 4 && kb < 8) {
#pragma unroll
        for (int j = 0; j < 8; ++j) v[j] = fast_sigmoid(v[j]);
    }
    v4u o; o.x = cvtpk(v[0], v[1]); o.y = cvtpk(v[2], v[3]); o.z = cvtpk(v[4], v[5]); o.w = cvtpk(v[6], v[7]);
    return o;
}
__device__ __forceinline__ void prep_issue(const bf16* PROJ, int tile, LAS unsigned char* buf, LAS unsigned char* dummy, int wave, int lane) {
    const int tok0 = tile * 16;
#pragma unroll
    for (int i = 0; i < 8; ++i) {
        const int ins = wave + 8 * i; int p = ins * 64 + lane; if (p > PR_PIECES - 1) p = PR_PIECES - 1;
        const int r = p / (PR_ROWB / 16), cp = p - r * (PR_ROWB / 16); int row = tok0 - 1 + r; if (row < 0) row = 0;
        const unsigned char* src = (const unsigned char*)PROJ + (size_t)row * (NPROJ * 2) + 3072 + 16 * cp;
        LAS unsigned char* dst = (ins < 61) ? buf + ins * 1024 : dummy;
        __builtin_amdgcn_global_load_lds((const unsigned*)src, (LAS unsigned*)dst, 16, 0, 0);
    }
}
template <bool HASV>
__device__ __forceinline__ void prep_phase(Frame& F, int l) {
    const bf16* PROJ = (const bf16*)(F.ws + WS_PROJ); unsigned char* SC = F.ws + WS_SCANIN; bf16* GB = (bf16*)(F.ws + WS_G); bf16* VF = (bf16*)(F.ws + WS_VF); bf16* BON = (bf16*)(F.ws + WS_BONUS);
    const bf16* WL = (const bf16*)(F.ws + WS_WLORA);
    const float* mu = inp(3) + (size_t)l * 1792; const float* muv = inp(4) + (size_t)(HASV ? l - 1 : 0) * 32;
    const int lane = F.lane, g = lane >> 4, c = lane & 15;
    const int h = F.wave; const int colh = 64 * h + 4 * c;
    const f32x4 mu_r = *(const f32x4*)(mu + colh), mu_k = *(const f32x4*)(mu + 512 + colh), mu_v = *(const f32x4*)(mu + 1024 + colh);
    const f32x4 dbase = *(const f32x4*)(inp(6) + (size_t)l * HW + colh), abase = *(const f32x4*)(inp(8) + (size_t)l * HW + colh);
    const f32x4 vbase = HASV ? *(const f32x4*)(inp(10) + (size_t)(l - 1) * HW + colh) : (f32x4){0.f, 0.f, 0.f, 0.f};
    const f32x4 kkp = *(const f32x4*)(inp(12) + (size_t)l * HW + colh), kap = *(const f32x4*)(inp(13) + (size_t)l * HW + colh), rkp = *(const f32x4*)(inp(14) + (size_t)l * HW + colh);
    constexpr int NKB = HASV ? 9 : 8;
    LAS unsigned char* dummy = F.lds + PR_DUMMY;
    int tile = F.vcu;
    if (tile < M / 16) prep_issue(PROJ, tile, F.lds, dummy, F.wave, lane);
    for (int it = 0; tile < M / 16; tile += F.G, ++it) {
        const int tok0 = tile * 16;
        LAS unsigned char* buf = F.lds + (it & 1) * PR_BUF;
        if (tile + F.G < M / 16) { prep_issue(PROJ, tile + F.G, F.lds + ((it + 1) & 1) * PR_BUF, dummy, F.wave, lane); asm volatile("s_waitcnt vmcnt(8)" ::: "memory"); }
        else asm volatile("s_waitcnt vmcnt(0)" ::: "memory");
        __builtin_amdgcn_s_barrier(); asm volatile("" ::: "memory");
        const int m0 = tok0 + 4 * g; const bool first0 = (m0 & (SEQ - 1)) == 0;
        u32x2 Rr[5], Kr[5], Vr[5], vfr[4];
#pragma unroll
        for (int e = 0; e < 5; ++e) { const LAS unsigned char* p = buf + (4 * g + e) * PR_ROWB + 2 * colh;
            Rr[e] = *(const LAS u32x2*)(p); Kr[e] = *(const LAS u32x2*)(p + 1024); Vr[e] = *(const LAS u32x2*)(p + 2048); }
        if (HASV) {
#pragma unroll
            for (int e = 0; e < 4; ++e) vfr[e] = *(const u32x2*)(VF + (size_t)(m0 + e) * HW + colh); }
        if (first0) { Rr[0] = (u32x2){0u, 0u}; Kr[0] = (u32x2){0u, 0u}; Vr[0] = (u32x2){0u, 0u}; }
        pg8::bf16x8 Aop[NKB];
        { const bool first = ((tok0 + c) & (SEQ - 1)) == 0; LAS unsigned char* aop = F.lds + PR_AOP;
          *(LAS v4u*)(aop + h * 1024 + lane * 16) = prep_aop(buf, c, g, first, h, mu, muv);
          if (HASV && h == 0) *(LAS v4u*)(aop + 8 * 1024 + lane * 16) = prep_aop(buf, c, g, first, 8, mu, muv);
          asm volatile("s_waitcnt lgkmcnt(0)" ::: "memory"); __builtin_amdgcn_s_barrier(); asm volatile("" ::: "memory");
#pragma unroll
          for (int kb = 0; kb < NKB; ++kb) Aop[kb] = *(const LAS pg8::bf16x8*)(aop + kb * 1024 + lane * 16);
        }
        const size_t srow = ((size_t)((m0 >> 12) * 8 + h) * SEQ + (m0 & (SEQ - 1))) * 1024;
        const pg8::f32x4 z4 = (pg8::f32x4){0.f, 0.f, 0.f, 0.f};
        { pg8::f32x4 aw[4];
#pragma unroll
          for (int nt = 0; nt < 4; ++nt) { aw[nt] = z4;
#pragma unroll
              for (int kb = 0; kb < 2; ++kb) { const pg8::bf16x8 b = *(const pg8::bf16x8*)(WL + (size_t)(colh + nt) * 64 + 32 * kb + 8 * g); aw[nt] = __builtin_amdgcn_mfma_f32_16x16x32_bf16(Aop[kb], b, aw[nt], 0, 0, 0); } }
#pragma unroll
          for (int e = 0; e < 4; ++e) { f32x4 w4;
#pragma unroll
              for (int nt = 0; nt < 4; ++nt) w4[nt] = fast_exp(-0.6065306597126334f * fast_sigmoid(dbase[nt] + aw[nt][e]));
              __builtin_nontemporal_store(w4, (f32x4*)(SC + srow + (size_t)e * 1024 + 16 * c)); } }
        { pg8::f32x4 ag[4];
#pragma unroll
          for (int nt = 0; nt < 4; ++nt) { ag[nt] = z4;
#pragma unroll
              for (int kb = 0; kb < 4; ++kb) { const pg8::bf16x8 b = *(const pg8::bf16x8*)(WL + 2 * 512 * 64 + (size_t)(colh + nt) * 128 + 32 * kb + 8 * g); ag[nt] = __builtin_amdgcn_mfma_f32_16x16x32_bf16(Aop[4 + kb], b, ag[nt], 0, 0, 0); } }
#pragma unroll
          for (int e = 0; e < 4; ++e) { u32x2 go; go.x = cvtpk(ag[0][e], ag[1][e]); go.y = cvtpk(ag[2][e], ag[3][e]); __builtin_nontemporal_store(go, (u32x2*)(GB + (size_t)(m0 + e) * HW + colh)); } }
        f32x4 rkeep[4], vkeep[4];
        { pg8::f32x4 av[4];
          if (HASV) {
#pragma unroll
              for (int nt = 0; nt < 4; ++nt) { const pg8::bf16x8 b = *(const pg8::bf16x8*)(WL + 2 * 512 * 64 + 512 * 128 + (size_t)(colh + nt) * 32 + 8 * g); av[nt] = __builtin_amdgcn_mfma_f32_16x16x32_bf16(Aop[NKB - 1], b, z4, 0, 0, 0); } }
#pragma unroll
          for (int e = 0; e < 4; ++e) {
              const float cv[4] = {bflo(Vr[e + 1].x), bfhi(Vr[e + 1].x), bflo(Vr[e + 1].y), bfhi(Vr[e + 1].y)}, pv[4] = {bflo(Vr[e].x), bfhi(Vr[e].x), bflo(Vr[e].y), bfhi(Vr[e].y)};
              const float cr[4] = {bflo(Rr[e + 1].x), bfhi(Rr[e + 1].x), bflo(Rr[e + 1].y), bfhi(Rr[e + 1].y)}, pr[4] = {bflo(Rr[e].x), bfhi(Rr[e].x), bflo(Rr[e].y), bfhi(Rr[e].y)};
              f32x4 v2, r2;
#pragma unroll
              for (int nt = 0; nt < 4; ++nt) { const float vv = cv[nt] + (pv[nt] - cv[nt]) * mu_v[nt]; r2[nt] = cr[nt] + (pr[nt] - cr[nt]) * mu_r[nt];
                  if (HASV) { const float vf = (nt & 1) ? bfhi(nt < 2 ? vfr[e].x : vfr[e].y) : bflo(nt < 2 ? vfr[e].x : vfr[e].y); v2[nt] = vv + (vf - vv) * fast_sigmoid(vbase[nt] + av[nt][e]); } else v2[nt] = vv; }
              { u32x2 ro; ro.x = cvtpk(r2[0], r2[1]); ro.y = cvtpk(r2[2], r2[3]); u32x2 vo2; vo2.x = cvtpk(v2[0], v2[1]); vo2.y = cvtpk(v2[2], v2[3]);
                __builtin_nontemporal_store(ro, (u32x2*)(SC + srow + (size_t)e * 1024 + 768 + 16 * (c & 7) + 8 * (c >> 3))); __builtin_nontemporal_store(vo2, (u32x2*)(SC + srow + (size_t)e * 1024 + 896 + 16 * (c & 7) + 8 * (c >> 3))); }
              rkeep[e] = r2; vkeep[e] = v2;
              if (!HASV) { u32x2 vo; vo.x = cvtpk(v2[0], v2[1]); vo.y = cvtpk(v2[2], v2[3]); *(u32x2*)(VF + (size_t)(m0 + e) * HW + colh) = vo; }
          } }
        { pg8::f32x4 aa[4];
#pragma unroll
          for (int nt = 0; nt < 4; ++nt) { aa[nt] = z4;
#pragma unroll
              for (int kb = 0; kb < 2; ++kb) { const pg8::bf16x8 b = *(const pg8::bf16x8*)(WL + 512 * 64 + (size_t)(colh + nt) * 64 + 32 * kb + 8 * g); aa[nt] = __builtin_amdgcn_mfma_f32_16x16x32_bf16(Aop[2 + kb], b, aa[nt], 0, 0, 0); } }
#pragma unroll
          for (int e = 0; e < 4; ++e) {
              const float ck[4] = {bflo(Kr[e + 1].x), bfhi(Kr[e + 1].x), bflo(Kr[e + 1].y), bfhi(Kr[e + 1].y)}, pk[4] = {bflo(Kr[e].x), bfhi(Kr[e].x), bflo(Kr[e].y), bfhi(Kr[e].y)};
              float kx[4], kr[4], a4[4]; float ss = 0.f;
#pragma unroll
              for (int nt = 0; nt < 4; ++nt) { kx[nt] = ck[nt] + (pk[nt] - ck[nt]) * mu_k[nt]; kr[nt] = kx[nt] * kkp[nt]; ss += kr[nt] * kr[nt]; a4[nt] = fast_sigmoid(abase[nt] + aa[nt][e]); }
              ss = red16(ss);
              const float inv = fminf(__builtin_amdgcn_rsqf(ss), 1e12f);
              f32x4 kn, bb, k2;
#pragma unroll
              for (int nt = 0; nt < 4; ++nt) { kn[nt] = kr[nt] * inv; bb[nt] = kn[nt] * a4[nt]; k2[nt] = kx[nt] * (1.0f + (a4[nt] - 1.0f) * kap[nt]); }
              __builtin_nontemporal_store(bb, (f32x4*)(SC + srow + (size_t)e * 1024 + 256 + 16 * c));
              { u32x2 ko; ko.x = cvtpk(kn[0], kn[1]); ko.y = cvtpk(kn[2], kn[3]); u32x2 k2o; k2o.x = cvtpk(k2[0], k2[1]); k2o.y = cvtpk(k2[2], k2[3]);
                __builtin_nontemporal_store(ko, (u32x2*)(SC + srow + (size_t)e * 1024 + 512 + 16 * (c & 7) + 8 * (c >> 3))); __builtin_nontemporal_store(k2o, (u32x2*)(SC + srow + (size_t)e * 1024 + 640 + 16 * (c & 7) + 8 * (c >> 3))); }
              { float bs = (rkeep[e][0] * k2[0] * rkp[0] + rkeep[e][1] * k2[1] * rkp[1]) + (rkeep[e][2] * k2[2] * rkp[2] + rkeep[e][3] * k2[3] * rkp[3]); bs = red16(bs);
                u32x2 bo; bo.x = cvtpk(bs * vkeep[e][0], bs * vkeep[e][1]); bo.y = cvtpk(bs * vkeep[e][2], bs * vkeep[e][3]); __builtin_nontemporal_store(bo, (u32x2*)(BON + (size_t)(m0 + e) * HW + colh)); }
          } }
        asm volatile("s_waitcnt lgkmcnt(0)" ::: "memory"); __builtin_amdgcn_s_barrier(); asm volatile("" ::: "memory");
    }
    asm volatile("s_waitcnt vmcnt(0)" ::: "memory"); __syncthreads();
}

constexpr int SC_T = 16, SC_NCH = SEQ / SC_T, SC_BUF = SC_T * 384 * 4, SC_YOFF = 4 * SC_BUF, SC_YBUF = SC_T * 16 * 4, SC_CONV = 104448;
__device__ __forceinline__ void scan_put(LAS unsigned char* dst_step, int p, v4u x) {
    if (p < 32) { *(LAS v4u*)(dst_step + ((p < 16) ? 16 * p : 512 + 16 * (p - 16))) = x; }
    else { const int qq = p - 32, vs = qq >> 3; const int off = ((vs == 0) ? 256 : (vs == 1) ? 768 : (vs == 2) ? 1024 : 1280) + 32 * (qq & 7);
        v4u lo, hi; lo.x = x.x << 16; lo.y = x.x & 0xffff0000u; lo.z = x.y << 16; lo.w = x.y & 0xffff0000u; hi.x = x.z << 16; hi.y = x.z & 0xffff0000u; hi.z = x.w << 16; hi.w = x.w & 0xffff0000u;
        *(LAS v4u*)(dst_step + off) = lo; *(LAS v4u*)(dst_step + off + 16) = hi; }
}
__device__ __forceinline__ void scan_put_bf(LAS unsigned char* dst, v4u x) {
    v4u lo, hi; lo.x = x.x << 16; lo.y = x.x & 0xffff0000u; lo.z = x.y << 16; lo.w = x.y & 0xffff0000u; hi.x = x.z << 16; hi.y = x.z & 0xffff0000u; hi.z = x.w << 16; hi.w = x.w & 0xffff0000u;
    *(LAS v4u*)(dst) = lo; *(LAS v4u*)(dst + 128) = hi;
}
__device__ __forceinline__ void scan_phase(Frame& F, int l) {
    const unsigned char* SC = F.ws + WS_SCANIN; float* YS = (float*)(F.ws + WS_YS);
    const int lane = F.lane, w = F.wave;
    for (int unit = F.vcu; unit < 256; unit += F.G) {
        const int bh = unit >> 2, q = unit & 3, b = bh >> 3, h = bh & 7;
        const GAS v4u* src = (const GAS v4u*)(SC + (size_t)bh * SEQ * 1024);
        const int hw = w - 4, lp = lane & 31, sp = (lane >> 5) + 4 * hw;
        const int lofs_f = (lp < 16 ? 16 * lp : 512 + 16 * (lp - 16));
        const int lofs_b = (((lp >> 3) == 0 ? 256 : (lp >> 3) == 1 ? 768 : (lp >> 3) == 2 ? 1024 : 1280) + 16 * (lp & 7));
        const GAS v4u* srcl = src + (sp * 64 + lp);
#define SCAN_SRC(chunk, i) srcl[(size_t)(chunk) * (SC_T * 64) + (2 * ((i) & 1)) * 64 + (((i) < 2) ? 0 : 32)]
#define SCAN_PUT(dstbase, i, x) do { LAS unsigned char* d_ = (dstbase) + (sp + 2 * ((i) & 1)) * 1536; if ((i) < 2) *(LAS v4u*)(d_ + lofs_f) = (x); else scan_put_bf(d_ + lofs_b, x); } while (0)
        v4u R[16]; int cidx = -1;
        LAS unsigned char* cscr = F.lds + SC_CONV + (w & 3) * 5120;
        __syncthreads();
        if (w >= 4) {
#pragma unroll
            for (int i = 0; i < 4; ++i) { R[i] = SCAN_SRC(0, i); R[4 + i] = SCAN_SRC(1, i); }
#pragma unroll
            for (int i = 0; i < 4; ++i) { SCAN_PUT(F.lds, i, R[i]); SCAN_PUT(F.lds + SC_BUF, i, R[4 + i]); }
#pragma unroll
            for (int i = 0; i < 4; ++i) { R[i] = SCAN_SRC(2, i); R[4 + i] = SCAN_SRC(3, i); }
        }
        __syncthreads();
        typedef float f32x2v __attribute__((ext_vector_type(2)));
        f32x2v S01 = (f32x2v){0.f, 0.f}, S23 = (f32x2v){0.f, 0.f};
        const int i4 = lane >> 4, j = lane & 15;
        if (w < 4) __builtin_amdgcn_s_setprio(3);
        for (int ch4 = 0; ch4 < SC_NCH; ch4 += 4) {
#pragma unroll
            for (int kp = 0; kp < 4; kp += 2) {
                if (w >= 4) {
#pragma unroll
                  for (int k = kp; k < kp + 2; ++k) { const int ch = ch4 + k;
                    if (ch + 2 < SC_NCH) { LAS unsigned char* dst = F.lds + ((ch + 2) & 3) * SC_BUF;
#pragma unroll
                        for (int i = 0; i < 4; ++i) SCAN_PUT(dst, i, R[4 * (k & 1) + i]); }
                    if (ch + 4 < SC_NCH) {
#pragma unroll
                        for (int i = 0; i < 4; ++i) R[4 * (k & 1) + i] = SCAN_SRC(ch + 4, i); }
                    if (ch > 1 && hw == (k & 3)) { const int t = lane >> 2, part = lane & 3;
                        const f32x4 y = *(const LAS f32x4*)(F.lds + SC_YOFF + ((ch - 2) & 3) * SC_YBUF + (t * 16 + 4 * part) * 4);
                        *(GAS f32x4*)(YS + ((size_t)b * SEQ + (ch - 2) * SC_T + t) * HW + 64 * h + 16 * q + 4 * part) = y; }
                    if (((hw + 2) & 3) == k) { if (cidx >= 0) { ConvItem ci = scan_item32(l, cidx); ci.WT = (bf16*)(F.ws + (size_t)ci.WT); conv_item32_finish(ci, lane, R, cscr); } cidx = -1; }
                    if (hw == k) { const int idx = (ch4 + hw) * F.G + F.vcu; ConvItem ci = scan_item32(l, idx); if (ci.ok) { conv_item32_load(ci, lane, R); cidx = idx; } }
                  }
                } else {
                  f32x4 o0w = {0.f, 0.f, 0.f, 0.f}, o0kk = o0w, o0b = o0w, o0k = o0w, o0r = o0w, o1w = o0w, o1kk = o0w, o1b = o0w, o1k = o0w, o1r = o0w; float o0v = 0.f, o1v = 0.f;
#pragma unroll
                  for (int k = kp; k < kp + 2; ++k) { const int ch = ch4 + k;
                    const LAS unsigned char* buf = F.lds + (ch & 3) * SC_BUF + 16 * j; LAS float* yb = (LAS float*)(F.lds + SC_YOFF + (ch & 3) * SC_YBUF) + 4 * w + i4;
                    const LAS unsigned char* vb = F.lds + (ch & 3) * SC_BUF + 1280 + (16 * q + 4 * w + i4) * 4;
#define SC_LD(o, p_, v_) do { const LAS unsigned char* p__ = (p_); o##w = *(const LAS f32x4*)(p__); o##kk = *(const LAS f32x4*)(p__ + 256); o##b = *(const LAS f32x4*)(p__ + 512); o##k = *(const LAS f32x4*)(p__ + 768); \
                        o##r = *(const LAS f32x4*)(p__ + 1024); o##v = *(const LAS float*)(v_); } while (0)
                    if (!(k & 1)) { SC_LD(o0, buf, vb); SC_LD(o1, buf + 1536, vb + 1536); }
                    float v8[SC_T / 2], pyl = 0.f; const bool b0 = (j & 1) != 0;
#pragma unroll
                    for (int t = 0; t < SC_T; ++t) {
                        f32x4 o2w = o1w, o2kk = o1kk, o2b = o1b, o2k = o1k, o2r = o1r; float o2v = o1v;
                        if (t + 2 < SC_T) SC_LD(o2, buf + (t + 2) * 1536, vb + (t + 2) * 1536);
                        else if (!(k & 1)) { const int no = (((ch + 1) & 3) - (ch & 3)) * SC_BUF + (t + 2 - SC_T) * 1536; SC_LD(o2, buf + no, vb + no); }
                        __builtin_amdgcn_sched_barrier(0x0006);
                        const f32x2v pa2 = S01 * (f32x2v){o0kk.x, o0kk.y} + S23 * (f32x2v){o0kk.z, o0kk.w};
                        const float sa = -red16(pa2.x + pa2.y);
                        S01 = (S01 * (f32x2v){o0w.x, o0w.y} + (f32x2v){o0k.x, o0k.y} * o0v) + (f32x2v){o0b.x, o0b.y} * sa;
                        S23 = (S23 * (f32x2v){o0w.z, o0w.w} + (f32x2v){o0k.z, o0k.w} * o0v) + (f32x2v){o0b.z, o0b.w} * sa;
                        const f32x2v py2 = S01 * (f32x2v){o0r.x, o0r.y} + S23 * (f32x2v){o0r.z, o0r.w};
                        { const float pyt = py2.x + py2.y;
                          if (t & 1) { const float keep = b0 ? pyt : pyl, send = b0 ? pyl : pyt; v8[t >> 1] = keep + dppf<0xB1>(send); } else pyl = pyt; }
                        o0w = o1w; o0kk = o1kk; o0b = o1b; o0k = o1k; o0r = o1r; o0v = o1v;
                        o1w = o2w; o1kk = o2kk; o1b = o2b; o1k = o2k; o1r = o2r; o1v = o2v;
                    }
#undef SC_LD
                    { const bool b1 = (j & 2) != 0, b2 = (j & 4) != 0, b3 = (j & 8) != 0;
                      float v4[4], v2[2];
#pragma unroll
                      for (int i = 0; i < 4; ++i) { const float keep = b1 ? v8[2 * i + 1] : v8[2 * i], send = b1 ? v8[2 * i] : v8[2 * i + 1]; v4[i] = keep + dppf<0x4E>(send); }
#pragma unroll
                      for (int i = 0; i < 2; ++i) { const float keep = b2 ? v4[2 * i + 1] : v4[2 * i], send = b2 ? v4[2 * i] : v4[2 * i + 1];
                          v2[i] = keep + dppf<0x1B>(dppf<0x141>(send)); }
                      const float keep = b3 ? v2[1] : v2[0], send = b3 ? v2[0] : v2[1];
                      yb[j * 16] = keep + dppf<0x141>(dppf<0x140>(send));
                    }
                  }
                }
                __syncthreads();
            }
        }
        __builtin_amdgcn_s_setprio(0);
        if (w >= 4 && cidx >= 0) { ConvItem ci = scan_item32(l, cidx); ci.WT = (bf16*)(F.ws + (size_t)ci.WT); conv_item32_finish(ci, lane, R, cscr); cidx = -1; }
        if (w == 4) { const int t = lane >> 2, part = lane & 3;
#pragma unroll
            for (int cc = SC_NCH - 2; cc < SC_NCH; ++cc) {
                const f32x4 y = *(const LAS f32x4*)(F.lds + SC_YOFF + (cc & 3) * SC_YBUF + (t * 16 + 4 * part) * 4);
                *(GAS f32x4*)(YS + ((size_t)b * SEQ + cc * SC_T + t) * HW + 64 * h + 16 * q + 4 * part) = y; } }
    }
}

constexpr int AT_PITCH = 144, AT_KOFF = 0, AT_VOFF = 40960;
struct AttnUnit { int p, dil, n, cls, b, h; };
__device__ __forceinline__ AttnUnit attn_decode(int u) { AttnUnit a; a.p = u >> 11; const int r = u & 2047; a.dil = 1 << (2 * a.p); const int nb = 32 >> (2 * a.p);
    a.n = r % nb; a.cls = (r / nb) % a.dil; const int bh = r >> 5; a.b = bh >> 3; a.h = bh & 7; return a; }
__device__ __forceinline__ void attn_load(const bf16* PROJ, const AttnUnit& a, int tid, int w, int g, int c16, v4u (&kq)[4], v4u (&vq)[4], pg8::bf16x8 (&qf)[2]) {
    const int row = tid >> 1, half = tid & 1; const int idx = 128 * (a.n - 1) + row;
    const int idc = idx < 0 ? 0 : idx;
    const bf16* kp = PROJ + ((size_t)a.b * SEQ + (size_t)idc * a.dil + a.cls) * NPROJ + 512 + 64 * a.h + 32 * half;
#pragma unroll
    for (int i = 0; i < 4; ++i) { kq[i] = *(const v4u*)(kp + 8 * i); vq[i] = *(const v4u*)(kp + 512 + 8 * i); }
    if (idx < 0) {
#pragma unroll
        for (int i = 0; i < 4; ++i) { kq[i] = (v4u){0u, 0u, 0u, 0u}; vq[i] = (v4u){0u, 0u, 0u, 0u}; } }
    const int qidx = 128 * a.n + 16 * w + c16; const size_t mq = (size_t)a.b * SEQ + (size_t)qidx * a.dil + a.cls;
    const bf16* qp = PROJ + mq * NPROJ + 64 * a.h + 8 * g; qf[0] = *(const pg8::bf16x8*)qp; qf[1] = *(const pg8::bf16x8*)(qp + 32);
}
__device__ __forceinline__ void attn_phase(Frame& F) {
    const bf16* PROJ = (const bf16*)(F.ws + WS_PROJ); unsigned char* PB = F.ws + WS_PROJ;
    const int lane = F.lane, w = F.wave, g = lane >> 4, c16 = lane & 15, tid = F.tid;
    LAS unsigned char* Ks = F.lds + AT_KOFF; LAS unsigned char* Vs = F.lds + AT_VOFF;
    __syncthreads();
    for (int i = tid; i < 16 * AT_PITCH / 4; i += 512) { ((LAS unsigned*)(Ks + 256 * AT_PITCH))[i] = 0u; ((LAS unsigned*)(Vs + 256 * AT_PITCH))[i] = 0u; }
    v4u kq[2][4], vq[2][4]; pg8::bf16x8 qn[2][2];
    const int u0 = F.vcu;
    if (u0 < 3 * 2048) attn_load(PROJ, attn_decode(u0), tid, w, g, c16, kq[0], vq[0], qn[0]);
    if (u0 + F.G < 3 * 2048) attn_load(PROJ, attn_decode(u0 + F.G), tid, w, g, c16, kq[1], vq[1], qn[1]);
    for (int ub = u0; ub < 3 * 2048; ub += 2 * F.G)
#pragma unroll
    for (int kk2 = 0; kk2 < 2; ++kk2) {
        const int u = ub + kk2 * F.G; if (u >= 3 * 2048) break;
        const AttnUnit a = attn_decode(u); const int p = a.p, dil = a.dil, n = a.n, cls = a.cls, b = a.b, h = a.h;
        __syncthreads();
        { const int row = tid >> 1, half = tid & 1;
#pragma unroll
          for (int i = 0; i < 4; ++i) { *(LAS v4u*)(Ks + row * AT_PITCH + 64 * half + 16 * i) = kq[kk2][i]; *(LAS v4u*)(Vs + row * AT_PITCH + 64 * half + 16 * i) = vq[kk2][i]; } }
        pg8::bf16x8 qf[2]; qf[0] = qn[kk2][0]; qf[1] = qn[kk2][1];
        const int qidx = 128 * n + 16 * w + c16; const size_t mq = (size_t)b * SEQ + (size_t)qidx * dil + cls;
        __syncthreads();
        if (u + 2 * F.G < 3 * 2048) attn_load(PROJ, attn_decode(u + 2 * F.G), tid, w, g, c16, kq[kk2], vq[kk2], qn[kk2]);
        pg8::f32x4 s[9];
#pragma unroll
        for (int jt = 0; jt < 9; ++jt) {
            const LAS unsigned char* kp = Ks + (16 * w + 16 * jt + c16) * AT_PITCH + 16 * g;
            const pg8::bf16x8 k0 = *(const LAS pg8::bf16x8*)kp, k1 = *(const LAS pg8::bf16x8*)(kp + 64);
            pg8::f32x4 a = (pg8::f32x4){0.f, 0.f, 0.f, 0.f};
            a = __builtin_amdgcn_mfma_f32_16x16x32_bf16(k0, qf[0], a, 0, 0, 0);
            a = __builtin_amdgcn_mfma_f32_16x16x32_bf16(k1, qf[1], a, 0, 0, 0);
            s[jt] = a;
        }
        const float NEG = -INFINITY; float mx = NEG;
#pragma unroll
        for (int jt = 0; jt < 9; ++jt)
#pragma unroll
            for (int e = 0; e < 4; ++e) { const int kw = 16 * w + 16 * jt + 4 * g + e; const int qw = 128 + 16 * w + c16;
                bool ok = true; if (jt == 0) ok = kw >= qw - 128; if (jt == 8) ok = kw <= qw; if (n == 0) ok = ok && (kw >= 128);
                if (!ok) s[jt][e] = NEG; mx = fmaxf(mx, s[jt][e]); }
        mx = fmaxf(mx, __shfl_xor(mx, 16)); mx = fmaxf(mx, __shfl_xor(mx, 32));
        float lsum = 0.f;
#pragma unroll
        for (int jt = 0; jt < 9; ++jt)
#pragma unroll
            for (int e = 0; e < 4; ++e) { const float pe = __builtin_amdgcn_exp2f((s[jt][e] - mx) * 1.4426950408889634f); s[jt][e] = pe; lsum += pe; }
        lsum += __shfl_xor(lsum, 16); lsum += __shfl_xor(lsum, 32);
        pg8::f32x4 o[4];
#pragma unroll
        for (int dt = 0; dt < 4; ++dt) o[dt] = (pg8::f32x4){0.f, 0.f, 0.f, 0.f};
#pragma unroll
        for (int jp = 0; jp < 5; ++jp) {
            v4u pw; pw.x = cvtpk(s[2 * jp][0], s[2 * jp][1]); pw.y = cvtpk(s[2 * jp][2], s[2 * jp][3]);
            if (jp < 4) { pw.z = cvtpk(s[2 * jp + 1][0], s[2 * jp + 1][1]); pw.w = cvtpk(s[2 * jp + 1][2], s[2 * jp + 1][3]); } else { pw.z = 0u; pw.w = 0u; }
            const pg8::bf16x8 pf = __builtin_bit_cast(pg8::bf16x8, pw);
            typedef short s4v __attribute__((ext_vector_type(4)));
            const LAS unsigned char* va = Vs + (16 * w + 32 * jp + 4 * g + (c16 >> 2)) * AT_PITCH + 8 * (c16 & 3);
#pragma unroll
            for (int dt = 0; dt < 4; ++dt) {
                const s4v lo = __builtin_amdgcn_ds_read_tr16_b64_v4i16((LAS s4v*)(va + 32 * dt));
                const s4v hi = __builtin_amdgcn_ds_read_tr16_b64_v4i16((LAS s4v*)(va + 32 * dt + 16 * AT_PITCH));
                o[dt] = __builtin_amdgcn_mfma_f32_16x16x32_bf16(__builtin_shufflevector(lo, hi, 0, 1, 2, 3, 4, 5, 6, 7), pf, o[dt], 0, 0, 0);
            }
        }
        const float il = 1.0f / lsum;
        bf16* op = (bf16*)(PB + mq * PROW + OP_OFF + 1024 * p) + 64 * h + 4 * g;
#pragma unroll
        for (int dt = 0; dt < 4; ++dt) { u32x2 ow; ow.x = cvtpk(o[dt][0] * il, o[dt][1] * il); ow.y = cvtpk(o[dt][2] * il, o[dt][3] * il); __builtin_nontemporal_store(ow, (u32x2*)(op + 16 * dt)); }
        if (g == 0) *(float*)(PB + mq * PROW + LSE_OFF + 4 * (8 * p + h)) = mx + __logf(lsum);
    }
}

__device__ __forceinline__ void post_phase(Frame& F, int l) {
    const float* YS = (const float*)(F.ws + WS_YS); const bf16* BON = (const bf16*)(F.ws + WS_BONUS); const bf16* GB = (const bf16*)(F.ws + WS_G);
    const unsigned char* PB = F.ws + WS_PROJ; bf16* MIX = (bf16*)(F.ws + WS_MIX);
    const int lane = F.lane, gw = F.vcu * NWAVES + F.wave, NGW = F.G * NWAVES;
    const int h = lane >> 3, c8 = 8 * (lane & 7);
    f32x4 lg0 = *(const f32x4*)(inp(15) + (size_t)l * HW + 8 * lane), lg1 = *(const f32x4*)(inp(15) + (size_t)l * HW + 8 * lane + 4);
    f32x4 lb0 = *(const f32x4*)(inp(16) + (size_t)l * HW + 8 * lane), lb1 = *(const f32x4*)(inp(16) + (size_t)l * HW + 8 * lane + 4);
    for (int m = gw; m < M; m += NGW) {
        float o8[8];
        { const float* lp = (const float*)(PB + (size_t)m * PROW + LSE_OFF); const float l0 = lp[h], l1 = lp[8 + h], l2 = lp[16 + h];
          const float mx = fmaxf(l0, fmaxf(l1, l2)); float w0 = fast_exp(l0 - mx), w1 = fast_exp(l1 - mx), w2 = fast_exp(l2 - mx); const float inv = 1.0f / (w0 + w1 + w2); w0 *= inv; w1 *= inv; w2 *= inv;
          const bf16* opp = (const bf16*)(PB + (size_t)m * PROW + OP_OFF) + 8 * lane; const v4u a0 = *(const v4u*)(opp), a1 = *(const v4u*)(opp + 512), a2 = *(const v4u*)(opp + 1024);
          const unsigned* p0 = (const unsigned*)&a0; const unsigned* p1 = (const unsigned*)&a1; const unsigned* p2 = (const unsigned*)&a2;
#pragma unroll
          for (int i = 0; i < 4; ++i) { o8[2 * i] = w0 * bflo(p0[i]) + w1 * bflo(p1[i]) + w2 * bflo(p2[i]); o8[2 * i + 1] = w0 * bfhi(p0[i]) + w1 * bfhi(p1[i]) + w2 * bfhi(p2[i]); } }
        v4u oa; oa.x = cvtpk(o8[0], o8[1]); oa.y = cvtpk(o8[2], o8[3]); oa.z = cvtpk(o8[4], o8[5]); oa.w = cvtpk(o8[6], o8[7]);
        __builtin_nontemporal_store(oa, (v4u*)(MIX + (size_t)m * D + 8 * lane));
        const f32x4 y0 = *(const f32x4*)(YS + (size_t)m * HW + 8 * lane), y1 = *(const f32x4*)(YS + (size_t)m * HW + 8 * lane + 4);
        const v4u bq = *(const v4u*)(BON + (size_t)m * HW + 8 * lane);
        const v4u gq = *(const v4u*)(GB + (size_t)m * HW + 8 * lane);
        float s = (y0.x + y0.y) + (y0.z + y0.w) + (y1.x + y1.y) + (y1.z + y1.w); s = red8(s);
        const float mean = s * (1.0f / 64.0f);
        const f32x4 d0 = y0 - mean, d1 = y1 - mean;
        float qv = (d0.x * d0.x + d0.y * d0.y) + (d0.z * d0.z + d0.w * d0.w) + (d1.x * d1.x + d1.y * d1.y) + (d1.z * d1.z + d1.w * d1.w); qv = red8(qv);
        const float rstd = 1.0f / sqrtf(qv * (1.0f / 64.0f) + GN_EPS);
        const f32x4 bn0 = (f32x4){bflo(bq.x), bfhi(bq.x), bflo(bq.y), bfhi(bq.y)}, bn1 = (f32x4){bflo(bq.z), bfhi(bq.z), bflo(bq.w), bfhi(bq.w)};
        const f32x4 yn0 = d0 * rstd * lg0 + lb0 + bn0, yn1 = d1 * rstd * lg1 + lb1 + bn1;
        v4u ob; ob.x = cvtpk(yn0.x * bflo(gq.x), yn0.y * bfhi(gq.x)); ob.y = cvtpk(yn0.z * bflo(gq.y), yn0.w * bfhi(gq.y)); ob.z = cvtpk(yn1.x * bflo(gq.z), yn1.y * bfhi(gq.z)); ob.w = cvtpk(yn1.z * bflo(gq.w), yn1.w * bfhi(gq.w));
        __builtin_nontemporal_store(ob, (v4u*)(MIX + (size_t)m * D + HW + 8 * lane));
    }
}

template <int MODE, bool ROUTE, bool LAST>
__device__ __forceinline__ void ln_phase(Frame& F, const bf16* Yb, const float* gam, const float* bet, const float* router, unsigned* cnt, bf16* XO = nullptr, const unsigned* tcnt = nullptr) {
    bf16* XB = (bf16*)(F.ws + WS_XB); if (XO == nullptr) XO = XB;
    int tslot0 = 0x7fffffff, tS = 1;
    if (MODE == 1 && tcnt != nullptr) { const TailPlan p = tail_plan(tcnt, D / 256, F.G, true); tS = p.S; if (tS > 1) tslot0 = p.pm0 * 256; }
    const int lane = F.lane, gw = F.vcu * NWAVES + F.wave, NGW = F.G * NWAVES;
    f32x4 gv[4], bv[4];
#pragma unroll
    for (int j = 0; j < 4; ++j) { gv[j] = *(const f32x4*)(gam + 4 * lane + 256 * j); bv[j] = *(const f32x4*)(bet + 4 * lane + 256 * j); }
    f32x4 rw[ROUTE ? 16 : 1][2];
    LAS unsigned* lcnt = (LAS unsigned*)F.lds;
    int my_e0 = 0, my_e1 = 0, my_p0 = 0, my_p1 = 0, my_m = -1; float my_g0 = 0.f, my_g1 = 0.f; int it_ = 0;
    int cwv[8] = {0, 0, 0, 0, 0, 0, 0, 0};
    if (ROUTE) { __syncthreads(); }
    if (ROUTE) {
#pragma unroll
        for (int j = 0; j < 4; ++j)
#pragma unroll
            for (int i = 0; i < 4; ++i) { const float* rp = router + (size_t)(4 * lane + 256 * j + i) * 8; rw[4 * j + i][0] = *(const f32x4*)rp; rw[4 * j + i][1] = *(const f32x4*)(rp + 4); }
    }
#define LN_LOAD(mm, XA, YA, YB2) do { _Pragma("unroll") for (int j = 0; j < 4; ++j) { XA[j] = *(const u32x2*)(XB + (size_t)(mm) * D + 4 * lane + 256 * j); \
        if (MODE == 0) YA[j] = *(const u32x2*)(Yb + (size_t)(mm) * D + 4 * lane + 256 * j); \
        else { YA[j] = *(const u32x2*)(Yb + (size_t)(2 * (mm)) * D + 4 * lane + 256 * j); YB2[j] = *(const u32x2*)(Yb + (size_t)(2 * (mm) + 1) * D + 4 * lane + 256 * j); } } } while (0)
    u32x2 nxa[4], nya[4], nyb[4];
    LN_LOAD(gw, nxa, nya, nyb);
    for (int m = gw; m < M; m += NGW) {
        f32x4 z[4]; float s = 0.f;
        u32x2 cxa[4], cya[4], cyb[4];
        {
#pragma unroll
            for (int j = 0; j < 4; ++j) { cxa[j] = nxa[j]; cya[j] = nya[j]; if (MODE != 0) cyb[j] = nyb[j]; }
            const int mn = (m + NGW < M) ? m + NGW : m;
            LN_LOAD(mn, nxa, nya, nyb);
        }
        f32x4 tadd[4];
        if (MODE == 1 && tS > 1) {
#pragma unroll
            for (int j = 0; j < 4; ++j) tadd[j] = (f32x4){0.f, 0.f, 0.f, 0.f};
            const int* chp = (const int*)(F.ws + WS_CHOICE) + (size_t)m * 8;
            const int sl[2] = {__builtin_amdgcn_readfirstlane(chp[6]), __builtin_amdgcn_readfirstlane(chp[7])};
#pragma unroll
            for (int jj = 0; jj < 2; ++jj) if (sl[jj] >= tslot0) {
                for (int qq = 1; qq < tS; ++qq) { const float* pr = (const float*)(F.ws + WS_PT) + ((size_t)(qq - 1) * PT_TILES * 256 + (sl[jj] - tslot0)) * D + 4 * lane;
#pragma unroll
                    for (int j = 0; j < 4; ++j) tadd[j] = tadd[j] + *(const f32x4*)(pr + 256 * j); } }
        }
#pragma unroll
        for (int j = 0; j < 4; ++j) {
            const u32x2 xa = cxa[j];
            f32x4 f;
            if (MODE == 0) { const u32x2 ya = cya[j]; f = (f32x4){bflo(ya.x), bfhi(ya.x), bflo(ya.y), bfhi(ya.y)}; }
            else { const u32x2 ya = cya[j], yb = cyb[j];
                   f = (f32x4){bflo(ya.x) + bflo(yb.x), bfhi(ya.x) + bfhi(yb.x), bflo(ya.y) + bflo(yb.y), bfhi(ya.y) + bfhi(yb.y)};
                   if (tS > 1) f = f + tadd[j]; }
            z[j] = (f32x4){bflo(xa.x), bfhi(xa.x), bflo(xa.y), bfhi(xa.y)} * DN_ALPHA + f;
            s += (z[j].x + z[j].y) + (z[j].z + z[j].w);
        }
        const float mean = wave_sum(s) * (1.0f / D); float s2 = 0.f;
#pragma unroll
        for (int j = 0; j < 4; ++j) { z[j] = z[j] - mean; s2 += (z[j].x * z[j].x + z[j].y * z[j].y) + (z[j].z * z[j].z + z[j].w * z[j].w); }
        const float rstd = 1.0f / sqrtf(wave_sum(s2) * (1.0f / D) + LN_EPS);
#pragma unroll
        for (int j = 0; j < 4; ++j) z[j] = z[j] * rstd * gv[j] + bv[j];
        if (LAST) {
#pragma unroll
            for (int j = 0; j < 4; ++j) *(GAS f32x4*)(F.out + (size_t)m * D + 4 * lane + 256 * j) = z[j];
        } else {
#pragma unroll
            for (int j = 0; j < 4; ++j) { u32x2 o; o.x = cvtpk(z[j].x, z[j].y); o.y = cvtpk(z[j].z, z[j].w); *(u32x2*)(XO + (size_t)m * D + 4 * lane + 256 * j) = o; }
        }
        if (ROUTE) {
            float lg[8];
#pragma unroll
            for (int e = 0; e < 8; ++e) lg[e] = 0.f;
#pragma unroll
            for (int j = 0; j < 4; ++j)
#pragma unroll
                for (int i = 0; i < 4; ++i) { const float xv = z[j][i]; const f32x4 ra = rw[ROUTE ? 4 * j + i : 0][0], rb = rw[ROUTE ? 4 * j + i : 0][1];
                    lg[0] += xv * ra.x; lg[1] += xv * ra.y; lg[2] += xv * ra.z; lg[3] += xv * ra.w; lg[4] += xv * rb.x; lg[5] += xv * rb.y; lg[6] += xv * rb.z; lg[7] += xv * rb.w; }
#pragma unroll
            for (int e = 0; e < 8; ++e) (void)e;
            {
              const bool b0 = (lane & 1) != 0, b1 = (lane & 2) != 0, b2 = (lane & 4) != 0;
              float v4[4], v2[2];
#pragma unroll
              for (int i = 0; i < 4; ++i) { const float keep = b0 ? lg[2 * i + 1] : lg[2 * i], send = b0 ? lg[2 * i] : lg[2 * i + 1]; v4[i] = keep + dppf<0xB1>(send); }
#pragma unroll
              for (int i = 0; i < 2; ++i) { const float keep = b1 ? v4[2 * i + 1] : v4[2 * i], send = b1 ? v4[2 * i] : v4[2 * i + 1]; v2[i] = keep + dppf<0x4E>(send); }
              const float keep = b2 ? v2[1] : v2[0], send = b2 ? v2[0] : v2[1];
              float v1 = keep + __builtin_bit_cast(float, __builtin_amdgcn_ds_swizzle(__builtin_bit_cast(int, send), 0x101F));
              v1 += __builtin_bit_cast(float, __builtin_amdgcn_ds_swizzle(__builtin_bit_cast(int, v1), 0x201F));
              v1 += __builtin_bit_cast(float, __builtin_amdgcn_ds_swizzle(__builtin_bit_cast(int, v1), 0x401F));
              v1 += __shfl_xor(v1, 32);
#pragma unroll
              for (int e = 0; e < 8; ++e) lg[e] = __builtin_bit_cast(float, __builtin_amdgcn_readlane(__builtin_bit_cast(int, v1), e));
            }
            int e0 = 0; float v0 = lg[0];
#pragma unroll
            for (int e = 1; e < 8; ++e) if (lg[e] > v0) { v0 = lg[e]; e0 = e; }
            int e1 = -1; float v1 = -INFINITY;
#pragma unroll
            for (int e = 0; e < 8; ++e) if (e != e0 && lg[e] > v1) { v1 = lg[e]; e1 = e; }
            const float g1 = 1.0f / (1.0f + __expf(v0 - v1)), g0 = 1.0f - g1;
            int p0 = 0, p1 = 0;
#pragma unroll
            for (int e = 0; e < 8; ++e) { if (e == e0) { p0 = cwv[e]; cwv[e] += 1; } if (e == e1) { p1 = cwv[e]; cwv[e] += 1; } }
            if (lane == it_) { my_e0 = e0; my_e1 = e1; my_p0 = (int)p0; my_p1 = (int)p1; my_g0 = g0; my_g1 = g1; my_m = m; }
            ++it_;
        }
    }
    if (ROUTE) {
        int mine = 0;
#pragma unroll
        for (int e = 0; e < 8; ++e) if (lane == e) mine = cwv[e];
        if (lane < 8) lcnt[F.wave * 8 + lane] = (unsigned)mine;
        __syncthreads();
        if (F.tid < 64) { const int w2 = F.tid >> 3, e = F.tid & 7; unsigned pre = 0u; for (int w3 = 0; w3 < w2; ++w3) pre += lcnt[w3 * 8 + e]; lcnt[64 + F.tid] = pre;
            if (w2 == 7) { const unsigned tot = pre + lcnt[56 + e]; ((int*)(F.ws + WS_CNTB))[F.vcu * 8 + e] = (int)tot; atomicAdd(cnt + e, tot); } }
        __syncthreads();
        if (my_m >= 0) { int* ch = (int*)(F.ws + WS_CHOICE) + (size_t)my_m * 8;
            ch[0] = my_e0; ch[1] = my_e1; ch[2] = my_p0 + (int)lcnt[64 + F.wave * 8 + my_e0]; ch[3] = my_p1 + (int)lcnt[64 + F.wave * 8 + my_e1]; ((float*)ch)[4] = my_g0; ((float*)ch)[5] = my_g1; }
    }
}

__device__ __forceinline__ void moe_build_phase(Frame& F, const unsigned* cnt) {
    const bf16* XB = (const bf16*)(F.ws + WS_XB); bf16* XS = (bf16*)(F.ws + WS_XS); int* RD = (int*)(F.ws + WS_ROWDST); float* RG = (float*)(F.ws + WS_ROWGATE);
    const int lane = F.lane, gw = F.vcu * NWAVES + F.wave, NGW = F.G * NWAVES;
    int off[9]; off[0] = 0;
#pragma unroll
    for (int e = 0; e < 8; ++e) off[e + 1] = off[e] + (int)(((cnt[e] + 255u) >> 8) << 8);
    LAS int* bb = (LAS int*)F.lds;
    __syncthreads(); if (F.tid < 8) bb[F.tid] = 0; __syncthreads();
    if (F.tid < F.vcu) { const int* cb = (const int*)(F.ws + WS_CNTB) + (size_t)F.tid * 8;
#pragma unroll
        for (int e = 0; e < 8; ++e) __hip_atomic_fetch_add(bb + e, cb[e], __ATOMIC_RELAXED, __HIP_MEMORY_SCOPE_WORKGROUP); }
    __syncthreads();
#pragma unroll
    for (int e = 0; e < 8; ++e) off[e] += bb[e];
    int* RS = (int*)(F.ws + WS_ROWSRC);
    for (int m = gw + lane * NGW; m < M; m += 64 * NGW) {
        const int* ch = (const int*)(F.ws + WS_CHOICE) + (size_t)m * 8;
        const v4u c4 = *(const v4u*)ch; const u32x2 g2 = *(const u32x2*)(ch + 4);
        const int e0 = (int)c4.x, e1 = (int)c4.y, p0 = (int)c4.z, p1 = (int)c4.w;
        int o0 = 0, o1 = 0;
#pragma unroll
        for (int e = 0; e < 8; ++e) { if (e == e0) o0 = off[e]; if (e == e1) o1 = off[e]; }
        const int s0 = o0 + p0, s1 = o1 + p1;
        RS[s0] = m; RS[s1] = m; RD[s0] = 2 * m; RD[s1] = 2 * m + 1; ((unsigned*)RG)[s0] = g2.x; ((unsigned*)RG)[s1] = g2.y;
        u32x2 fin; fin.x = (unsigned)s0; fin.y = (unsigned)s1; *(u32x2*)((int*)(F.ws + WS_CHOICE) + (size_t)m * 8 + 6) = fin;
    }
#pragma unroll
    for (int e = 0; e < 8; ++e) off[e] -= bb[e];
#pragma unroll
    for (int e = 0; e < 8; ++e) {
        const int lo = off[e] + (int)cnt[e], hi = off[e + 1];
        for (int s = lo + gw * 64 + lane; s < hi; s += NGW * 64) { RS[s] = -1; RD[s] = -1; RG[s] = 0.f; }
    }
}

__global__ void __launch_bounds__(NWAVES * 64, 2) fwd(Args args) {
    extern __shared__ __attribute__((aligned(16))) unsigned char lds_raw[];
    Frame F0;
    F0.lds = (LAS unsigned char*)lds_raw;
    F0.tid = 0; F0.lane = 0; F0.wave = 0;
    F0.G = gridDim.x; { const int bx = blockIdx.x; F0.vcu = (F0.G % 8 == 0) ? (bx % 8) * (F0.G / 8) + bx / 8 : bx; }
    F0.ws = args.ws; F0.out = args.out;
    volatile LAS unsigned* MISC = (volatile LAS unsigned*)(F0.lds + MISC_OFF);
    gu32* ctl = (gu32*)(F0.ws + WS_CTL);
    for (int u = threadIdx.x; u < (LDS_BYTES - RING_BYTES) / 4; u += NWAVES * 64) ((LAS unsigned*)(F0.lds + RING_BYTES))[u] = 0u;
    __syncthreads();
    const int lo = args.ph_lo, hi = args.ph_hi;
    const bool multi = (hi - lo) > 1;
    XcdBarrier bar; bar.bar = (unsigned*)(ctl + CW_BAR); bar.x = 0; bar.st = nullptr;
    if (multi) bar = xcd_barrier_post((unsigned*)(ctl + CW_BAR), MISC + 8);
#ifndef PHMASK
#define PHMASK 0xfff
#endif
#define IN(k) (((PHMASK >> ((k) % PH_PER_LAYER)) & 1) && lo <= (k) && (k) < hi)
#ifndef PROBE_TIME
#define PROBE_TIME -1
#endif
    unsigned long long pt_last = 0ull, pt_acc = 0ull;
    if (PROBE_TIME >= 0) pt_last = __builtin_amdgcn_s_memrealtime();
#define PT_STAMP(k) do { if (PROBE_TIME >= 0) { const unsigned long long now_ = __builtin_amdgcn_s_memrealtime(); if (((k) % PH_PER_LAYER) == PROBE_TIME) pt_acc += now_ - pt_last; pt_last = now_; } } while (0)
#define SEAM(k) do { if (IN((k) + 1) && IN(k)) { xcd_barrier(bar); if ((PROBE_DUP >> 12) & 1) xcd_barrier(bar); PT_STAMP(k); } } while (0)

#define REP(k, ...) do { __VA_ARGS__; if ((PROBE_DUP >> (k)) & 1) { __VA_ARGS__; } } while (0)
#define PHASE_FRAME() Frame F = F0; { int t_ = threadIdx.x; asm volatile("" : "+v"(t_)); F.tid = t_; F.lane = t_ & 63; F.wave = __builtin_amdgcn_readfirstlane(t_ >> 6); }
#define LAYER_BODY(moe) do { const int P0 = l * PH_PER_LAYER; const int li = l >> 1; (void)li; \
         \
        if (l == 0 && IN(P0 + 0)) { PHASE_FRAME(); REP(0, conv_mixer_weights(F, l); conv_x(F)); SEAM(P0 + 0); } \
         \
        if (IN(P0 + 1)) { PHASE_FRAME(); \
            pg8::Gemm g{(const pg8::bf16_t*)(F.ws + WS_XB), (const pg8::bf16_t*)(F.ws + WS_WIN), M, NPROJ, D}; NaiveOrder S; S.init(M, NPROJ, F.G, (int)blockIdx.x); \
            pg8::EpiBf16<0> E{(pg8::bf16_t*)(F.ws + WS_PROJ), NPROJ, nullptr, 0, 0, 1.f}; \
            REP(1, pg8::gemm_phase<pg8::EpiBf16<0>, NaiveOrder, true, true>(F.lds, g, S, E)); \
            SEAM(P0 + 1); \
        } \
         \
        if (IN(P0 + 2)) { PHASE_FRAME(); REP(2, if (l == 0) prep_phase<false>(F, l); else prep_phase<true>(F, l)); SEAM(P0 + 2); } \
         \
        if (IN(P0 + 3)) { PHASE_FRAME(); REP(3, scan_phase(F, l)); if (!IN(P0 + 4)) SEAM(P0 + 3); } \
        if (IN(P0 + 4)) { PHASE_FRAME(); __syncthreads(); REP(4, attn_phase(F)); SEAM(P0 + 4); } \
         \
        if (IN(P0 + 5)) { PHASE_FRAME(); REP(5, post_phase(F, l)); SEAM(P0 + 5); } \
         \
        if (IN(P0 + 6)) { PHASE_FRAME(); \
            pg8::Gemm g{(const pg8::bf16_t*)(F.ws + WS_MIX), (const pg8::bf16_t*)(F.ws + WS_WOUT), M, D, D}; pg8::StaticOrder S; S.init(M, D, F.G, (int)blockIdx.x); \
            pg8::EpiBf16<0> E{(pg8::bf16_t*)(F.ws + WS_Y), D, nullptr, 0, 0, 1.f}; \
            REP(6, pg8::gemm_phase<pg8::EpiBf16<0>, pg8::StaticOrder, true, true>(F.lds, g, S, E)); \
            if (DBG_RECONV == 1 || (DBG_RECONV == 2 && moe) || (DBG_RECONV == 3 && !moe)) { __syncthreads(); conv_ffn_weights(F, l); } \
            SEAM(P0 + 6); \
        } \
         \
        if (IN(P0 + 7)) { PHASE_FRAME(); unsigned* cnt = (unsigned*)(F.ws + WS_CTL) + CW_MOE + 64 * li; \
            const float* gam = inp(18) + (size_t)l * D; const float* bet = inp(19) + (size_t)l * D; \
            if ((PROBE_DUP >> 11) & 1) ln_phase<0, false, false>(F, (const bf16*)(F.ws + WS_Y), gam, bet, nullptr, nullptr, (bf16*)(F.ws + WS_BIG)); \
            if (moe) ln_phase<0, true, false>(F, (const bf16*)(F.ws + WS_Y), gam, bet, inp(25) + (size_t)li * D * 8, cnt); \
            else ln_phase<0, false, false>(F, (const bf16*)(F.ws + WS_Y), gam, bet, nullptr, nullptr); \
            SEAM(P0 + 7); \
        } \
         \
        if (moe && IN(P0 + 8)) { PHASE_FRAME(); unsigned* cnt = (unsigned*)(F.ws + WS_CTL) + CW_MOE + 64 * li; REP(8, moe_build_phase(F, cnt)); SEAM(P0 + 8); } \
         \
        if (IN(P0 + 9)) { PHASE_FRAME(); unsigned* cnt = (unsigned*)(F.ws + WS_CTL) + CW_MOE + 64 * li; \
            if (!moe) { \
                pg8::Gemm g{(const pg8::bf16_t*)(F.ws + WS_XB), (const pg8::bf16_t*)(F.ws + WS_WF), M, 2 * DFF, D}; NaiveOrder S; S.init(M, 2 * DFF, F.G, (int)blockIdx.x); \
                EpiSwiglu E{(bf16*)(F.ws + WS_HID), DFF}; \
                REP(9, pg8::gemm_phase<EpiSwiglu, NaiveOrder, true, true>(F.lds, g, S, E)); \
            } else { \
                pg8::Gemm g{(const pg8::bf16_t*)(F.ws), (const pg8::bf16_t*)(F.ws + WS_WF), MOE_ROWS, 2 * DFE, D, (const int*)(F.ws + WS_ROWSRC), (unsigned)WS_XB, (unsigned)WS_ZROW}; GroupedOrder S; S.init(cnt, 2 * DFE / 256, F.G, (int)blockIdx.x, (unsigned)(2 * DFE * D * 2)); \
                EpiSwiglu E{(bf16*)(F.ws + WS_HID), DFE}; \
                REP(9, pg8::gemm_phase<EpiSwiglu, GroupedOrder, true, true, true>(F.lds, g, S, E)); \
            } \
            SEAM(P0 + 9); \
        } \
         \
        if (IN(P0 + 10)) { PHASE_FRAME(); unsigned* cnt = (unsigned*)(F.ws + WS_CTL) + CW_MOE + 64 * li; \
            if (!moe) { \
                pg8::Gemm g{(const pg8::bf16_t*)(F.ws + WS_HID), (const pg8::bf16_t*)(F.ws + WS_WFD), M, D, DFF}; pg8::StaticOrder S; S.init(M, D, F.G, (int)blockIdx.x); \
                pg8::EpiBf16<0> E{(pg8::bf16_t*)(F.ws + WS_Y2), D, nullptr, 0, 0, 1.f}; \
                REP(10, pg8::gemm_phase<pg8::EpiBf16<0>, pg8::StaticOrder, true, true>(F.lds, g, S, E)); \
            } else { \
                pg8::Gemm g{(const pg8::bf16_t*)(F.ws + WS_HID), (const pg8::bf16_t*)(F.ws + WS_WFD), MOE_ROWS, D, DFE}; GroupedOrder S; S.init(cnt, D / 256, F.G, (int)blockIdx.x, (unsigned)(D * DFE * 2), true, DFE); \
                EpiMoeDown E{(bf16*)(F.ws + WS_YPAIR), (const int*)(F.ws + WS_ROWDST), (const float*)(F.ws + WS_ROWGATE), (float*)(F.ws + WS_PT), tail_plan(cnt, D / 256, F.G, true).pm0 * 256}; \
                REP(10, pg8::gemm_phase<EpiMoeDown, GroupedOrder, true, true>(F.lds, g, S, E)); \
            } \
            SEAM(P0 + 10); \
        } \
         \
        if (IN(P0 + 11)) { PHASE_FRAME(); \
            const float* gam = inp(20) + (size_t)l * D; const float* bet = inp(21) + (size_t)l * D; \
            if ((PROBE_DUP >> 11) & 1) { if (moe) ln_phase<1, false, false>(F, (const bf16*)(F.ws + WS_YPAIR), gam, bet, nullptr, nullptr, (bf16*)(F.ws + WS_BIG)); else ln_phase<0, false, false>(F, (const bf16*)(F.ws + WS_Y2), gam, bet, nullptr, nullptr, (bf16*)(F.ws + WS_BIG)); } \
            if (l == DEPTH - 1) ln_phase<1, false, true>(F, (const bf16*)(F.ws + WS_YPAIR), gam, bet, nullptr, nullptr, nullptr, (const unsigned*)(F.ws + WS_CTL) + CW_MOE + 64 * li); \
            else if (moe) ln_phase<1, false, false>(F, (const bf16*)(F.ws + WS_YPAIR), gam, bet, nullptr, nullptr, nullptr, (const unsigned*)(F.ws + WS_CTL) + CW_MOE + 64 * li); \
            else ln_phase<0, false, false>(F, (const bf16*)(F.ws + WS_Y2), gam, bet, nullptr, nullptr); \
            if (l + 1 < DEPTH) { __syncthreads(); REP(0, conv_mixer_rest(F, l + 1)); } \
            if (l + 1 < DEPTH && lo <= P0 + 11 && P0 + 13 < hi) { xcd_barrier(bar); PT_STAMP(P0 + 11); } \
        } \
    } while (0)
    { constexpr int l = 0; LAYER_BODY(false); }
    { constexpr int l = 1; LAYER_BODY(true); }
    { constexpr int l = 2; LAYER_BODY(false); }
    { constexpr int l = 3; LAYER_BODY(true); }
    if (PROBE_TIME >= 0) { PT_STAMP(N_PHASES - 1); if (blockIdx.x == 0 && threadIdx.x == 0) { const unsigned long long t0_ = __builtin_amdgcn_s_memrealtime(); while (__builtin_amdgcn_s_memrealtime() - t0_ < 2ull * pt_acc) __builtin_amdgcn_s_sleep(8); } }
#undef IN
#undef SEAM
}

extern "C" void kernel_launch(void* const* d_in, const int* in_sizes, int n_in, void* d_out, int out_size, void* d_ws, size_t ws_size, hipStream_t stream) {
    static int grid = 0;
    if (grid == 0) {
        if (n_in != 29 || in_sizes[0] != M * D || out_size != M * D || ws_size < WS_END) { fprintf(stderr, "kernel_launch: unexpected shapes / workspace (%d inputs, ws %zu)\n", n_in, ws_size); grid = -1; return; }
        int dev = 0, cus = 0;
        if (hipGetDevice(&dev) != hipSuccess || hipDeviceGetAttribute(&cus, hipDeviceAttributeMultiprocessorCount, dev) != hipSuccess) { grid = -1; return; }
        if (hipFuncSetAttribute((const void*)fwd, hipFuncAttributeMaxDynamicSharedMemorySize, LDS_BYTES) != hipSuccess) { grid = -1; return; }
        grid = cus;
    }
    if (grid < 0) return;
    (void)hipMemsetAsync((char*)d_ws + WS_CTL, 0, CTL_ZERO_BYTES, stream);
    Args a{};
    for (int i = 0; i < 29; ++i) a.in[i] = (const float*)d_in[i];
    a.out = (float*)d_out; a.ws = (unsigned char*)d_ws;
#ifndef ONE_LAUNCH
#define ONE_LAUNCH 1
#endif
    if (ONE_LAUNCH) { a.ph_lo = 0; a.ph_hi = N_PHASES; hipLaunchKernelGGL(fwd, dim3(grid), dim3(NWAVES * 64), LDS_BYTES, stream, a); }
    else {
        for (int ph = 0; ph < N_PHASES; ++ph) {
            const int k = ph % PH_PER_LAYER, l = ph / PH_PER_LAYER;
            if (k == 8 && (l & 1) == 0) continue;
            a.ph_lo = ph; a.ph_hi = ph + 1;
            hipLaunchKernelGGL(fwd, dim3(grid), dim3(NWAVES * 64), LDS_BYTES, stream, a);
        }
    }
}
```

```cpp
#include <hip/hip_runtime.h>
#include <cstdio>
#include <cstdint>
#include <cmath>
namespace pg8 {
#define PG8_LAS __attribute__((address_space(3)))
typedef unsigned short bf16_t;
typedef short bf16x8 __attribute__((ext_vector_type(8)));
typedef float f32x4 __attribute__((ext_vector_type(4)));
typedef unsigned u32x4 __attribute__((ext_vector_type(4)));
constexpr int BM = 256, BK = 64, HALF = 128, HTB = HALF * BK * 2  , STAGE_BYTES = 8 * HTB, NXCD = 8, WGM = 8;

__host__ __device__ __forceinline__ int lds_byte(int r, int c) { const int st = (r >> 4) * 2 + (c >> 5), rr = r & 15, cc = c & 31, ob = rr * 64 + cc * 2; return st * 1024 + (ob ^ (((ob >> 9) & 1) << 5)); }
__host__ __device__ __forceinline__ void stage_rc(int b, int& R, int& C) { const int st = b / 1024, sb = b % 1024, swz = sb ^ (((sb >> 9) & 1) << 5); R = (st >> 1) * 16 + swz / 64; C = (st & 1) * 32 + (swz % 64) / 2; }
__host__ __device__ __forceinline__ int perm32(int rho) { const int n = rho >> 4, i = rho & 15; return 8 * (i >> 2) + 4 * n + (i & 3); }

struct Unit { int pm, pn; unsigned bofs; unsigned kofs; int nt; int q; };
struct Gemm { const bf16_t* A; const bf16_t* Bt; int M, N, K; const int* rowsrc = nullptr; unsigned aoff = 0u, zoff = 0u; };

struct StaticOrder {
    int nM, nN, nwg, G, c;
    __host__ __device__ void init(int M, int N, int G_, int c_) { nM = M / BM; nN = N / BM; nwg = nM * nN; G = G_; c = c_; }
    __host__ __device__ bool next(int i, Unit& u) const {
        const long L = (long)i * G + c; if (L >= nwg) return false;
        int wgid = (int)L; { const int q = nwg / NXCD, r = nwg % NXCD, xcd = wgid % NXCD, off = wgid / NXCD; wgid = (xcd < r ? xcd * (q + 1) : r * (q + 1) + (xcd - r) * q) + off; }
        const int nig = WGM * nN, gid = wgid / nig, fm = gid * WGM, gsz = (nM - fm) < WGM ? (nM - fm) : WGM;
        u.pm = fm + ((wgid % nig) % gsz); u.pn = (wgid % nig) / gsz; u.bofs = 0u; u.kofs = 0u; u.nt = 0; u.q = 0; return true;
    }
    __device__ __forceinline__ void a_ready(const Unit&) const {}
    __device__ __forceinline__ void done(const Unit&) const {}
};

__device__ __forceinline__ unsigned cvt_pk_bf16(float lo, float hi) { unsigned r; asm volatile("v_cvt_pk_bf16_f32 %0, %1, %2" : "=v"(r) : "v"(lo), "v"(hi)); return r; }
typedef float f32x2 __attribute__((ext_vector_type(2)));
__device__ __forceinline__ f32x2 gelu_pk(f32x2 v) {
    const f32x2 av = __builtin_elementwise_abs(v), d = av * 0.2316418882f + 1.0f;
    f32x2 t; t.x = __builtin_amdgcn_rcpf(d.x); t.y = __builtin_amdgcn_rcpf(d.y);
    f32x2 q = t * 0.5307027145f + (-0.7265760135f); q = q * t + 0.7107068705f; q = q * t + (-0.142248368f); q = q * t + 0.127414796f; q = q * t;
    const f32x2 s = (v * v) * (-0.72134752044f);
    f32x2 e; e.x = __builtin_amdgcn_exp2f(s.x); e.y = __builtin_amdgcn_exp2f(s.y);
    const f32x2 m = v * (q * e), r = v - m;
    f32x2 o; o.x = v.x < 0.f ? m.x : r.x; o.y = v.y < 0.f ? m.y : r.y; return o;
}

template <int ACT  > struct EpiBf16 {
    static constexpr bool PERM = true, AFTER_DRAIN = false; static_assert(ACT == 0 || ACT == 1, "EpiBf16: ACT is 0 (none) or 1 (gelu_pk)");
    bf16_t* O; int ldc; const float* bias; int split_cols; size_t split_stride; float scale0;
    __device__ __forceinline__ void operator()(const f32x4 (&acc)[2][2][4][2], const Unit& u, int wr, int wc, int fr, int fq) const {
        const int row0 = u.pm * BM + wr * 64 + fr; int colt = u.pn * BM; bf16_t* base = O;
        float sc = 1.f; if (split_cols) { const int t = colt / split_cols; base += (size_t)t * split_stride; colt -= t * split_cols; if (t == 0) sc = scale0; }
        const int col0 = colt + wc * 32 + 8 * fq, bcol0 = u.pn * BM + wc * 32 + 8 * fq;
        f32x4 bv[2][2];
#pragma unroll
        for (int bj = 0; bj < 2; ++bj)
#pragma unroll
            for (int n = 0; n < 2; ++n) bv[bj][n] = bias ? *(const f32x4*)(bias + bcol0 + bj * HALF + 4 * n) : (f32x4){0.f, 0.f, 0.f, 0.f};
#pragma unroll
        for (int ai = 0; ai < 2; ++ai)
#pragma unroll
            for (int m = 0; m < 4; ++m) { bf16_t* rowp = base + (size_t)(row0 + ai * HALF + m * 16) * ldc + col0;
#pragma unroll
                for (int bj = 0; bj < 2; ++bj) { f32x4 v0 = acc[ai][bj][m][0] + bv[bj][0], v1 = acc[ai][bj][m][1] + bv[bj][1];
                    if (ACT == 1) { f32x2 a = gelu_pk((f32x2){v0[0], v0[1]}), b = gelu_pk((f32x2){v0[2], v0[3]}), c = gelu_pk((f32x2){v1[0], v1[1]}), d = gelu_pk((f32x2){v1[2], v1[3]});
                        v0 = (f32x4){a.x, a.y, b.x, b.y}; v1 = (f32x4){c.x, c.y, d.x, d.y}; }
                    v0 = v0 * sc; v1 = v1 * sc; u32x4 w; w.x = cvt_pk_bf16(v0[0], v0[1]); w.y = cvt_pk_bf16(v0[2], v0[3]); w.z = cvt_pk_bf16(v1[0], v1[1]); w.w = cvt_pk_bf16(v1[2], v1[3]);
                    *(u32x4*)(rowp + bj * HALF) = w; } }
    }
};

template <class Epi, class Sched, bool ALIGN_EPI = false, bool SP2 = false, bool GATHER = false>
__device__ __forceinline__ void gemm_phase(PG8_LAS unsigned char* lds, const Gemm g, const Sched& S, const Epi& E) {
    int tid_l = threadIdx.x; asm volatile("" : "+v"(tid_l));
    const int tid = tid_l, wid = __builtin_amdgcn_readfirstlane(tid >> 6), lane = tid & 63, wr = wid >> 2, wc = wid & 3, fr = lane & 15, fq = lane >> 4;
    const int K = g.K; int nt = K / BK;
    unsigned voffA[2], voffB[2]; int rowA[2]; unsigned colA[2];
#pragma unroll
    for (int i = 0; i < 2; ++i) { int R, C; stage_rc(tid * 16 + i * 8192, R, C); const int Rb = Epi::PERM ? ((R & ~31) + perm32(R & 31)) : R;
        voffA[i] = (unsigned)(R * K + C) * 2u; voffB[i] = (unsigned)(Rb * K + C) * 2u; rowA[i] = R; colA[i] = (unsigned)C * 2u; }
    unsigned gC[2][2] = {{0u, 0u}, {0u, 0u}}, gN[2][2] = {{0u, 0u}, {0u, 0u}};
#define PG8_GOFF(dst, pm_) do { _Pragma("unroll") for (int h_ = 0; h_ < 2; ++h_) _Pragma("unroll") for (int i_ = 0; i_ < 2; ++i_) { const int rs_ = g.rowsrc[(pm_) * BM + h_ * HALF + rowA[i_]]; \
        dst[h_][i_] = (rs_ >= 0 ? g.aoff + (unsigned)rs_ * (unsigned)(K * 2) : g.zoff) + colA[i_]; } } while (0)
#define PG8_STAGE_A(bufoff, ptr, h, G) do { if constexpr (GATHER) PG8_STAGE(bufoff, ptr, G[h]); else PG8_STAGE(bufoff, (ptr) + (h) * hstep, voffA); } while (0)
    const size_t kstep = (size_t)(BK * 2);
    const size_t hstep = (size_t)HALF * K * 2;
    const size_t tstep = 2 * hstep;
    const unsigned ldsw = (unsigned)wid * 1024u;
    const int aoff = lds_byte(wr * 64 + fr, fq * 8), boff = lds_byte(wc * 32 + fr, fq * 8);
#define PG8_SA(b, h) (((b) * 2 + (h)) * HTB)
#define PG8_SB(b, h) ((4 + (b) * 2 + (h)) * HTB)
#define PG8_STAGE(bufoff, gbase, voff) do { _Pragma("unroll") for (int _i = 0; _i < 2; ++_i) \
        __builtin_amdgcn_global_load_lds((const unsigned*)((const char*)(gbase) + (voff)[_i]), (PG8_LAS unsigned*)(lds + (bufoff) + ldsw + _i * 8192), 16, 0, 0); } while (0)
#define PG8_LDA(dst, b, h) do { _Pragma("unroll") for (int m = 0; m < 4; ++m) _Pragma("unroll") for (int k = 0; k < 2; ++k) dst[m][k] = *(const PG8_LAS bf16x8*)(lds + PG8_SA(b, h) + aoff + m * 2048 + k * 1024); } while (0)
#define PG8_LDB(dst, b, h) do { _Pragma("unroll") for (int n = 0; n < 2; ++n) _Pragma("unroll") for (int k = 0; k < 2; ++k) dst[n][k] = *(const PG8_LAS bf16x8*)(lds + PG8_SB(b, h) + boff + n * 2048 + k * 1024); } while (0)
#define PG8_MMA(ai, bj, At, Bt) do { __builtin_amdgcn_s_setprio(1); _Pragma("unroll") for (int m = 0; m < 4; ++m) _Pragma("unroll") for (int n = 0; n < 2; ++n) _Pragma("unroll") for (int k = 0; k < 2; ++k) \
        acc[ai][bj][m][n] = __builtin_amdgcn_mfma_f32_16x16x32_bf16(Bt[n][k], At[m][k], acc[ai][bj][m][n], 0, 0, 0); __builtin_amdgcn_s_setprio(0); } while (0)
#define PG8_WAIT_V(n) asm volatile("s_waitcnt vmcnt(" #n ")" ::: "memory")
#define PG8_WAIT_L(n) asm volatile("s_waitcnt lgkmcnt(" #n ")" ::: "memory")
#define PG8_BAR __builtin_amdgcn_s_barrier()
#define PG8_SCHED __builtin_amdgcn_sched_barrier(0)
    Unit cur, nxt; int ui = 0;
    if (!S.next(0, cur)) return;
    f32x4 acc[2][2][4][2];
#pragma unroll
    for (int a = 0; a < 2; ++a)
#pragma unroll
        for (int b = 0; b < 2; ++b)
#pragma unroll
            for (int m = 0; m < 4; ++m)
#pragma unroll
                for (int n = 0; n < 2; ++n) acc[a][b][m][n] = (f32x4){0.f, 0.f, 0.f, 0.f};
    bf16x8 At[4][2], B0[2][2], B1[2][2];
    const char* cA = (const char*)g.A + (GATHER ? (size_t)0 : (size_t)cur.pm * tstep) + cur.kofs; if constexpr (GATHER) PG8_GOFF(gC, cur.pm);
    const char* cB = (const char*)g.Bt + (size_t)cur.bofs + (size_t)cur.pn * tstep + cur.kofs; if (cur.nt) nt = cur.nt;
    S.a_ready(cur);
    if constexpr (SP2) {
        PG8_STAGE(PG8_SB(0, 0), cB, voffB); PG8_STAGE(PG8_SB(0, 1), cB + hstep, voffB); PG8_STAGE_A(PG8_SA(0, 0), cA, 0, gC); PG8_STAGE_A(PG8_SA(0, 1), cA, 1, gC);
        if (wr == 1) PG8_BAR;
        PG8_WAIT_V(2); PG8_BAR;
        PG8_STAGE(PG8_SB(1, 0), cB + kstep, voffB); PG8_STAGE_A(PG8_SA(1, 0), cA + kstep, 0, gC); PG8_STAGE(PG8_SB(1, 1), cB + hstep + kstep, voffB);
        PG8_WAIT_V(6); PG8_BAR;
    } else {
        PG8_STAGE(PG8_SB(0, 0), cB, voffB); PG8_STAGE(PG8_SA(0, 0), cA, voffA); PG8_STAGE(PG8_SB(0, 1), cB + hstep, voffB); PG8_STAGE(PG8_SA(0, 1), cA + hstep, voffA);
        if (wr == 1) PG8_BAR;
        PG8_WAIT_V(4); PG8_BAR;
        PG8_STAGE(PG8_SB(1, 0), cB + kstep, voffB); PG8_STAGE(PG8_SA(1, 0), cA + kstep, voffA); PG8_STAGE(PG8_SB(1, 1), cB + hstep + kstep, voffB);
        PG8_WAIT_V(6); PG8_BAR;
    }
    for (;;) {
        const bool has_next = S.next(ui + 1, nxt);
        const char* nA = has_next ? (const char*)g.A + (GATHER ? (size_t)0 : (size_t)nxt.pm * tstep) + nxt.kofs : cA;
        const char* nB = has_next ? (const char*)g.Bt + (size_t)nxt.bofs + (size_t)nxt.pn * tstep + nxt.kofs : cB;
        PG8_LAS unsigned char* gtbl = lds + STAGE_BYTES + 4096 + (ui & 1) * 1024;
        if constexpr (GATHER) { if (has_next && wid < 4) __builtin_amdgcn_global_load_lds((const unsigned*)(g.rowsrc + nxt.pm * BM + 64 * wid + lane), (PG8_LAS unsigned*)(gtbl + 256 * wid), 4, 0, 0); }
        for (int t = 0; t < nt; t += 2) {
            const bool last = (t == nt - 2);
            const char* a1 = cA + (size_t)(t + 1) * kstep;
            const char* a2 = last ? nA : cA + (size_t)(t + 2) * kstep; const char* b2 = last ? nB : cB + (size_t)(t + 2) * kstep;
            const char* a3 = a2 + kstep; const char* b3 = b2 + kstep;
            if (last && has_next) S.a_ready(nxt);
            unsigned g2[2][2] = {{gC[0][0], gC[0][1]}, {gC[1][0], gC[1][1]}};
            if constexpr (GATHER) { if (last && has_next) { asm volatile("" ::: "memory");
                _Pragma("unroll") for (int h_ = 0; h_ < 2; ++h_) _Pragma("unroll") for (int i_ = 0; i_ < 2; ++i_) { const int rs_ = *(const PG8_LAS int*)(gtbl + (h_ * HALF + rowA[i_]) * 4); gN[h_][i_] = (rs_ >= 0 ? g.aoff + (unsigned)rs_ * (unsigned)(K * 2) : g.zoff) + colA[i_]; g2[h_][i_] = gN[h_][i_]; } } }
            if constexpr (SP2) {
            PG8_LDB(B0, 0, 0); PG8_LDB(B1, 0, 1); PG8_SCHED; PG8_LDA(At, 0, 0); PG8_STAGE_A(PG8_SA(1, 1), a1, 1, gC);
            PG8_WAIT_V(8); PG8_WAIT_L(0); PG8_BAR; PG8_MMA(0, 0, At, B0); PG8_MMA(0, 1, At, B1); PG8_BAR; PG8_SCHED;
            PG8_LDA(At, 0, 1); PG8_STAGE(PG8_SB(0, 0), b2, voffB); PG8_STAGE(PG8_SB(0, 1), b2 + hstep, voffB); PG8_STAGE_A(PG8_SA(0, 0), a2, 0, g2);
            PG8_WAIT_V(8); PG8_WAIT_L(0); PG8_BAR; PG8_MMA(1, 0, At, B0); PG8_MMA(1, 1, At, B1); PG8_BAR; PG8_SCHED;
            PG8_LDB(B0, 1, 0); PG8_LDB(B1, 1, 1); PG8_SCHED; PG8_LDA(At, 1, 0); PG8_STAGE_A(PG8_SA(0, 1), a2, 1, g2);
            PG8_WAIT_V(8); PG8_WAIT_L(0); PG8_BAR; PG8_MMA(0, 0, At, B0); PG8_MMA(0, 1, At, B1); PG8_BAR; PG8_SCHED;
            PG8_LDA(At, 1, 1); PG8_STAGE(PG8_SB(1, 0), b3, voffB); PG8_STAGE(PG8_SB(1, 1), b3 + hstep, voffB); PG8_STAGE_A(PG8_SA(1, 0), a3, 0, g2);
            PG8_WAIT_V(8); PG8_WAIT_L(0); PG8_BAR; PG8_MMA(1, 0, At, B0); PG8_MMA(1, 1, At, B1); PG8_BAR; PG8_SCHED;
            } else {
            PG8_LDB(B0, 0, 0); PG8_SCHED; PG8_LDA(At, 0, 0); PG8_STAGE(PG8_SA(1, 1), a1 + hstep, voffA);
            PG8_WAIT_L(8); PG8_BAR; PG8_WAIT_L(0); PG8_MMA(0, 0, At, B0); PG8_BAR; PG8_SCHED;
            PG8_LDB(B1, 0, 1); PG8_STAGE(PG8_SB(0, 0), b2, voffB);
            PG8_BAR; PG8_WAIT_L(0); PG8_MMA(0, 1, At, B1); PG8_BAR;
            PG8_LDA(At, 0, 1); PG8_STAGE(PG8_SA(0, 0), a2, voffA);
            PG8_BAR; PG8_WAIT_L(0); PG8_MMA(1, 0, At, B0); PG8_BAR; PG8_SCHED;
            PG8_STAGE(PG8_SB(0, 1), b2 + hstep, voffB);
            PG8_WAIT_V(6); PG8_BAR; PG8_MMA(1, 1, At, B1); PG8_BAR;
            PG8_LDB(B0, 1, 0); PG8_SCHED; PG8_LDA(At, 1, 0); PG8_STAGE(PG8_SA(0, 1), a2 + hstep, voffA);
            PG8_WAIT_L(8); PG8_BAR; PG8_WAIT_L(0); PG8_MMA(0, 0, At, B0); PG8_BAR; PG8_SCHED;
            PG8_LDB(B1, 1, 1); PG8_STAGE(PG8_SB(1, 0), b3, voffB);
            PG8_BAR; PG8_WAIT_L(0); PG8_MMA(0, 1, At, B1); PG8_BAR;
            PG8_LDA(At, 1, 1); PG8_STAGE(PG8_SA(1, 0), a3, voffA);
            PG8_BAR; PG8_WAIT_L(0); PG8_MMA(1, 0, At, B0); PG8_BAR; PG8_SCHED;
            PG8_STAGE(PG8_SB(1, 1), b3 + hstep, voffB);
            PG8_WAIT_V(6); PG8_BAR; PG8_MMA(1, 1, At, B1); PG8_BAR;
            }
        }
        if constexpr (ALIGN_EPI) { if (wr == 0) PG8_BAR; }
        if constexpr (!Epi::AFTER_DRAIN) { E(acc, cur, wr, wc, fr, fq); S.done(cur); }
        if (!has_next) break;
#pragma unroll
        for (int a = 0; a < 2; ++a)
#pragma unroll
            for (int b = 0; b < 2; ++b)
#pragma unroll
                for (int m = 0; m < 4; ++m)
#pragma unroll
                    for (int n = 0; n < 2; ++n) acc[a][b][m][n] = (f32x4){0.f, 0.f, 0.f, 0.f};
        cur = nxt; cA = nA; cB = nB; ++ui; nt = cur.nt ? cur.nt : K / BK;
        if constexpr (GATHER) { gC[0][0] = gN[0][0]; gC[0][1] = gN[0][1]; gC[1][0] = gN[1][0]; gC[1][1] = gN[1][1]; }
        if constexpr (ALIGN_EPI) { if (wr == 1) PG8_BAR; }
    }
    PG8_WAIT_V(0);
    if constexpr (!ALIGN_EPI) { if (wr == 0) PG8_BAR; }
    PG8_BAR;
    if constexpr (Epi::AFTER_DRAIN) { E.fused(acc, cur, wr, wc, fr, fq, lds, wid, lane); S.done(cur); }
#undef PG8_SA
#undef PG8_SB
#undef PG8_STAGE
#undef PG8_STAGE_A
#undef PG8_GOFF
#undef PG8_LDA
#undef PG8_LDB
#undef PG8_MMA
#undef PG8_WAIT_V
#undef PG8_WAIT_L
#undef PG8_BAR
#undef PG8_SCHED
}
}
#define GAS __attribute__((address_space(1)))
#define LAS __attribute__((address_space(3)))
typedef unsigned short bf16;
typedef unsigned v4u __attribute__((ext_vector_type(4)));
typedef float f32x4 __attribute__((ext_vector_type(4)));
typedef short bf16x8 __attribute__((ext_vector_type(8)));
typedef GAS unsigned gu32;
typedef GAS unsigned long long gu64;
#define RLX_AGENT __ATOMIC_RELAXED, __HIP_MEMORY_SCOPE_AGENT
#define LDS_WAIT() asm volatile("s_waitcnt lgkmcnt(0)" ::: "memory")
#define VM_WAIT() asm volatile("s_waitcnt vmcnt(0)" ::: "memory")
__device__ __forceinline__ unsigned long long rt() { return __builtin_amdgcn_s_memrealtime(); }
__device__ __forceinline__ unsigned f2bf(float f) { unsigned u = __builtin_bit_cast(unsigned, f); return (u + 0x7fffu + ((u >> 16) & 1u)) >> 16; }
__device__ __forceinline__ unsigned pk2(float lo, float hi) { return f2bf(lo) | (f2bf(hi) << 16); }

#define XB_TMO      128
#define XB_XCNT(j)  (256  + 64 * (j))
#define XB_XSUB(j)  (1280 + 64 * (j))
#define XB_XGEN(j)  (2304 + 64 * (j))
#define XB_TOP      3328
#define XB_TOPGEN   3392
#define XCD_BAR_WORDS 3456
#define XB_SPIN_CAP (1u << 18)

__device__ __forceinline__ unsigned xb_ld(unsigned* p)              { return __hip_atomic_load(p, __ATOMIC_RELAXED, __HIP_MEMORY_SCOPE_AGENT); }
__device__ __forceinline__ unsigned xb_add(unsigned* p, unsigned v) { return __hip_atomic_fetch_add(p, v, __ATOMIC_RELAXED, __HIP_MEMORY_SCOPE_AGENT); }
__device__ __forceinline__ unsigned xb_xcc_id() { return (unsigned)__builtin_amdgcn_s_getreg((3 << 11) | 20) & 0xFu; }
#define XB_SPIN(cond, bar) do { unsigned _sp = 0; while (cond) { __builtin_amdgcn_s_sleep(1); \
    if ((++_sp & 255u) == 0u) { if (xb_ld(&(bar)[XB_TMO])) break; if (_sp > XB_SPIN_CAP) { atomicAdd(&(bar)[XB_TMO], 1u); break; } } } } while (0)

struct XcdBarrier {
    unsigned* bar; unsigned x;
    volatile LAS unsigned* st;
};

__device__ __forceinline__ XcdBarrier xcd_barrier_post(unsigned* bar, volatile LAS unsigned* st) {
    XcdBarrier b; b.bar = bar; b.x = xb_xcc_id(); b.st = st;
    if (threadIdx.x == 0) (void)xb_add(&bar[XB_XCNT(b.x)], 1u);
    return b;
}
__device__ __forceinline__ void xcd_barrier_complete(unsigned* bar, unsigned x, unsigned& nloc, unsigned& nx) {
    const unsigned G = gridDim.x * gridDim.y * gridDim.z;
    unsigned sum, cnt, mine, sp = 0u;
    for (;;) {
        sum = 0u; cnt = 0u; mine = 0u;
#pragma unroll
        for (unsigned j = 0; j < 16; ++j) { const unsigned c = xb_ld(&bar[XB_XCNT(j)]); sum += c; cnt += (c > 0u) ? 1u : 0u; mine = (j == x) ? c : mine; }
        if (sum == G) break;
        __builtin_amdgcn_s_sleep(1);
        if ((++sp & 255u) == 0u) { if (xb_ld(&bar[XB_TMO])) break; if (sp > XB_SPIN_CAP) { atomicAdd(&bar[XB_TMO], 1u); break; } }
    }
    nloc = mine > 0u ? mine : 1u; nx = cnt > 0u ? cnt : 1u;
}

__device__ __forceinline__ void xcd_barrier(const XcdBarrier& b) {
    asm volatile("s_waitcnt vmcnt(0)" ::: "memory");
    __syncthreads();
    if (threadIdx.x == 0) {
        unsigned* bar = b.bar;
        __builtin_amdgcn_s_waitcnt(0);
        unsigned nloc = b.st[0], nx = b.st[1];
        if (nloc == 0u) { xcd_barrier_complete(bar, b.x, nloc, nx); b.st[0] = nloc; b.st[1] = nx; }
        const unsigned old = xb_add(&bar[XB_XSUB(b.x)], 1u);
        const unsigned gen = old / nloc;
        if (old + 1u == (gen + 1u) * nloc) {
            __builtin_amdgcn_fence(__ATOMIC_RELEASE, "agent");
            asm volatile("s_waitcnt vmcnt(0)" ::: "memory");
            const unsigned og = xb_add(&bar[XB_TOP], 1u);
            const unsigned tg = og / nx;
            if (og + 1u == (tg + 1u) * nx) xb_add(&bar[XB_TOPGEN], 1u);
            else XB_SPIN(xb_ld(&bar[XB_TOPGEN]) == tg, bar);
            __builtin_amdgcn_fence(__ATOMIC_ACQUIRE, "agent");
            xb_add(&bar[XB_XGEN(b.x)], 1u);
            asm volatile("s_waitcnt vmcnt(0)" ::: "memory");
        } else {
            XB_SPIN(xb_ld(&bar[XB_XGEN(b.x)]) == gen, bar);
            __builtin_amdgcn_fence(__ATOMIC_ACQUIRE, "agent");
            asm volatile("s_waitcnt vmcnt(0)" ::: "memory");
        }
    }
    __syncthreads();
}

constexpr int NWAVES = 8;
constexpr int BATCH = 8, SEQ = 4096, M = BATCH * SEQ, D = 1024, DEPTH = 4;
constexpr int NPROJ = 3584;
constexpr int HW = 512;
constexpr int DFF = 2816, DFE = 3584, NEXP = 8;
constexpr int MOE_ROWS = 2 * M + NEXP * 256;
constexpr float DN_ALPHA = 1.681792830507429f;
constexpr float LN_EPS = 1e-5f, GN_EPS = 64e-5f;
constexpr int PH_PER_LAYER = 12, N_PHASES = DEPTH * PH_PER_LAYER;

constexpr size_t MiB = 1u << 20;
constexpr int SC_ROW = 768;
constexpr size_t WS_CTL = 0, CTL_ZERO_BYTES = 1 * MiB, WS_ZROW = 768 * 1024;
constexpr size_t WS_WIN = 2 * MiB, WS_WOUT = 9 * MiB, WS_WLORA = 11 * MiB;
constexpr size_t WS_WF = 12 * MiB, WS_WFD = WS_WF + 112 * MiB;
constexpr size_t WS_XB = 180 * MiB, WS_VF = 244 * MiB, WS_BIG = 276 * MiB;
constexpr size_t WS_PROJ = WS_BIG, WS_SCANIN = WS_BIG + 224 * MiB, WS_BONUS = WS_BIG + 480 * MiB, WS_G = WS_BIG + 608 * MiB;
constexpr size_t WS_YS = WS_BIG + 512 * MiB;
constexpr size_t WS_MIX = WS_SCANIN + 192 * MiB, WS_Y = WS_SCANIN + 64 * MiB;
constexpr int OP_OFF = 3072, LSE_OFF = 6144, PROW = NPROJ * 2;
constexpr size_t WS_HID = WS_BIG, WS_XS = WS_BIG + 464 * MiB, WS_YPAIR = WS_XS, WS_Y2 = WS_XS;
constexpr size_t WS_ROWSRC = WS_BIG + 630 * MiB, WS_ROWDST = WS_BIG + 600 * MiB, WS_ROWGATE = WS_BIG + 601 * MiB, WS_CHOICE = WS_BIG + 602 * MiB;
constexpr size_t WS_CNTB = WS_BIG + 603 * MiB;
constexpr size_t WS_PT = WS_BIG + 604 * MiB;
constexpr int PT_TILES = 8;
constexpr size_t WS_WOUT2 = WS_BIG + 640 * MiB;
constexpr size_t WS_END = WS_BIG + 642 * MiB;
static_assert(WS_XS + (size_t)MOE_ROWS * D * 2 <= WS_ROWDST && WS_HID + (size_t)MOE_ROWS * DFE * 2 <= WS_XS, "ws map");
static_assert(WS_SCANIN + (size_t)M * 8 * SC_ROW <= WS_MIX && WS_MIX + (size_t)M * D * 2 <= WS_BONUS && WS_YS + (size_t)M * HW * 4 <= WS_ROWDST, "ws map");
constexpr int CW_BAR = 4096;
constexpr int CW_MOE = 512;

constexpr int LDS_BYTES = 147456, RING_BYTES = 131072, MISC_OFF = RING_BYTES + 320;

#ifndef PROBE_DUP
#define PROBE_DUP 0
#endif
#ifndef DBG_SYNC_CONV
#define DBG_SYNC_CONV 0
#endif
#ifndef DBG_RECONV
#define DBG_RECONV 0
#endif
struct Args { const float* in[29]; float* out; unsigned char* ws; int ph_lo, ph_hi; };

__device__ __forceinline__ float bf2f(unsigned short h) { return __builtin_bit_cast(float, (unsigned)h << 16); }
__device__ __forceinline__ float u2f(unsigned u) { return __builtin_bit_cast(float, u); }
__device__ __forceinline__ float bflo(unsigned w) { return __builtin_bit_cast(float, w << 16); }
__device__ __forceinline__ float bfhi(unsigned w) { return __builtin_bit_cast(float, w & 0xffff0000u); }
typedef float f32x2_t __attribute__((ext_vector_type(2))); typedef __bf16 bf16x2_t __attribute__((ext_vector_type(2)));
__device__ __forceinline__ unsigned cvtpk(float lo, float hi) { const f32x2_t v = {lo, hi}; const bf16x2_t b = __builtin_convertvector(v, bf16x2_t); return __builtin_bit_cast(unsigned, b); }
typedef unsigned u32x2 __attribute__((ext_vector_type(2)));
template <int CTRL> __device__ __forceinline__ float dppf(float x) { return __builtin_bit_cast(float, __builtin_amdgcn_update_dpp(0, __builtin_bit_cast(int, x), CTRL, 0xf, 0xf, false)); }
__device__ __forceinline__ float red4(float x) { x += dppf<0xB1>(x); x += dppf<0x4E>(x); return x; }
__device__ __forceinline__ float red8(float x) { x = red4(x); x += dppf<0x141>(x); return x; }
__device__ __forceinline__ float red16(float x) { x = red8(x); x += dppf<0x140>(x); return x; }
__device__ __forceinline__ float wave_sum(float v) {
#pragma unroll
    for (int o = 1; o < 64; o <<= 1) v += __shfl_xor(v, o);
    return v;
}
__device__ __forceinline__ float fast_exp(float x) { return __builtin_amdgcn_exp2f(x * 1.4426950408889634f); }
__device__ __forceinline__ float fast_sigmoid(float x) { return __builtin_amdgcn_rcpf(1.0f + fast_exp(-x)); }
__device__ __forceinline__ float fast_tanh(float x) { const float e = fast_exp(-2.0f * fabsf(x)); const float t = (1.0f - e) * __builtin_amdgcn_rcpf(1.0f + e); return x < 0.f ? -t : t; }

__device__ __forceinline__ const float* inp(int k) {
    typedef const volatile unsigned long long __attribute__((address_space(4))) * kp_t;
    const unsigned long long v = *(kp_t)((const char __attribute__((address_space(4)))*)__builtin_amdgcn_kernarg_segment_ptr() + 8 * k);
    const unsigned lo = __builtin_amdgcn_readfirstlane((unsigned)v), hi = __builtin_amdgcn_readfirstlane((unsigned)(v >> 32));
    return (const float*)(((unsigned long long)hi << 32) | lo);
}
struct Frame {
    LAS unsigned char* lds;
    int tid, lane, wave, vcu, G;
    unsigned char* ws;
    float* out;
};

__device__ __forceinline__ void conv_item(const float* W, int K, int N, int k0, int n0, bf16* WT, int ldk, int orow0, float scale, LAS float* scr, int lane) {
#pragma unroll 8
    for (int i = 0; i < 32; ++i) { const int kk = 2 * i + (lane >> 5); if (k0 + kk < K) scr[kk * 33 + (lane & 31)] = W[(size_t)(k0 + kk) * N + n0 + (lane & 31)] * scale; }
    LDS_WAIT(); asm volatile("" ::: "memory");
    const int c = lane & 7;
    if (k0 + 8 * c < K) {
#pragma unroll
        for (int j = 0; j < 4; ++j) { const int n = (lane >> 3) + 8 * j; const LAS float* s = scr + (8 * c) * 33 + n;
            v4u o; o.x = cvtpk(s[0 * 33], s[1 * 33]); o.y = cvtpk(s[2 * 33], s[3 * 33]); o.z = cvtpk(s[4 * 33], s[5 * 33]); o.w = cvtpk(s[6 * 33], s[7 * 33]);
            *(GAS v4u*)(WT + (size_t)(orow0 + n) * ldk + k0 + 8 * c) = o; }
    }
    LDS_WAIT(); asm volatile("" ::: "memory");
}
__device__ __forceinline__ void conv_item64(const float* W, int N, int k0, int n0, bf16* WT, int ldk, int orow0, float scale, LAS unsigned char* scr, int lane) {
    const int q = lane >> 4, c4 = 4 * (lane & 15);
    f32x4 v[16];
#pragma unroll
    for (int i = 0; i < 8; ++i) { const float* p = W + (size_t)(k0 + 8 * i + 2 * q) * N + n0 + c4; v[2 * i] = *(const GAS f32x4*)p; v[2 * i + 1] = *(const GAS f32x4*)(p + N); }
#pragma unroll
    for (int i = 0; i < 8; ++i) { const f32x4 a = v[2 * i] * scale, b2 = v[2 * i + 1] * scale; LAS unsigned char* d = scr + (8 * i + 2 * q) * 2;
#pragma unroll
        for (int c = 0; c < 4; ++c) *(LAS unsigned*)(d + (c4 + c) * 144) = cvtpk(a[c], b2[c]); }
    LDS_WAIT(); asm volatile("" ::: "memory");
    const int ch = lane & 7;
#pragma unroll
    for (int j = 0; j < 8; ++j) { const int n = (lane >> 3) + 8 * j; const v4u o = *(const LAS v4u*)(scr + n * 144 + 16 * ch);
        *(GAS v4u*)(WT + (size_t)(orow0 + n) * ldk + k0 + 8 * ch) = o; }
    LDS_WAIT(); asm volatile("" ::: "memory");
}
struct ConvItem { const float* W; bf16* WT; int N, k0, n0, ldk, orow0; bool ok; float scale = 1.0f; };
__device__ __forceinline__ void conv_item64_load(const ConvItem& c, int lane, v4u (&v)[16]) {
    const int q = lane >> 4, c4 = 4 * (lane & 15);
#pragma unroll
    for (int i = 0; i < 8; ++i) { const float* p = c.W + (size_t)(c.k0 + 8 * i + 2 * q) * c.N + c.n0 + c4; v[2 * i] = *(const GAS v4u*)p; v[2 * i + 1] = *(const GAS v4u*)(p + c.N); }
}
__device__ __forceinline__ void conv_item64_finish(const ConvItem& c, int lane, const v4u (&v)[16], LAS unsigned char* scr) {
    const int q = lane >> 4, c4 = 4 * (lane & 15);
#pragma unroll
    for (int i = 0; i < 8; ++i) { LAS unsigned char* d = scr + (8 * i + 2 * q) * 2; const v4u a = v[2 * i], b2 = v[2 * i + 1];
        *(LAS unsigned*)(d + (c4 + 0) * 144) = cvtpk(u2f(a.x), u2f(b2.x));
        *(LAS unsigned*)(d + (c4 + 1) * 144) = cvtpk(u2f(a.y), u2f(b2.y));
        *(LAS unsigned*)(d + (c4 + 2) * 144) = cvtpk(u2f(a.z), u2f(b2.z));
        *(LAS unsigned*)(d + (c4 + 3) * 144) = cvtpk(u2f(a.w), u2f(b2.w)); }
    LDS_WAIT(); asm volatile("" ::: "memory");
    const int ch = lane & 7;
#pragma unroll
    for (int j = 0; j < 8; ++j) { const int n = (lane >> 3) + 8 * j; const v4u o = *(const LAS v4u*)(scr + n * 144 + 16 * ch);
        *(GAS v4u*)(c.WT + (size_t)(c.orow0 + n) * c.ldk + c.k0 + 8 * ch) = o; }
    LDS_WAIT(); asm volatile("" ::: "memory");
}
__device__ __forceinline__ ConvItem ffn_item(int l, int idx) {
    ConvItem c; const int i = l >> 1; const bool moe = (l & 1) != 0;
    const int dff = moe ? DFE : DFF, nb_gu = dff / 64, it_gu = (D / 64) * nb_gu, it_dn = (dff / 64) * (D / 64), per = 2 * it_gu + it_dn;
    const int e = idx / per, r = idx - e * per; c.ok = moe ? (e < NEXP) : (e < 1);
    const int ee = c.ok ? e : 0;
    bf16* WGU = (bf16*)0; (void)WGU;
    if (r < 2 * it_gu) { const int half = r >= it_gu, it = r - half * it_gu, kb = it / nb_gu, nb = it - kb * nb_gu, n0 = 64 * nb;
        c.W = (moe ? inp(half ? 27 : 26) : inp(half ? 23 : 22)) + ((size_t)i * (moe ? NEXP : 1) + ee) * D * dff; c.N = dff; c.k0 = 64 * kb; c.n0 = n0; c.ldk = D;
        c.orow0 = 256 * (n0 >> 7) + (n0 & 127) + 128 * half; c.WT = (bf16*)(size_t)(WS_WF + (size_t)ee * 2 * dff * D * 2); }
    else { const int it = r - 2 * it_gu, kb = it / (D / 64), nb = it - kb * (D / 64);
        c.W = (moe ? inp(28) : inp(24)) + ((size_t)i * (moe ? NEXP : 1) + ee) * dff * D; c.N = D; c.k0 = 64 * kb; c.n0 = 64 * nb; c.ldk = dff; c.orow0 = 64 * nb;
        c.WT = (bf16*)(size_t)(WS_WFD + (size_t)ee * D * dff * 2); }
    return c;
}
__device__ __forceinline__ void conv_item32_load(const ConvItem& c, int lane, v4u (&v)[16]) {
    const int q = lane >> 4, c4 = 4 * (lane & 15);
#pragma unroll
    for (int i = 0; i < 4; ++i) { const float* p = c.W + (size_t)(c.k0 + 8 * i + 2 * q) * c.N + c.n0 + c4; v[8 + 2 * i] = *(const GAS v4u*)p; v[8 + 2 * i + 1] = *(const GAS v4u*)(p + c.N); }
}
__device__ __forceinline__ void conv_item32_finish(const ConvItem& c, int lane, const v4u (&v)[16], LAS unsigned char* scr) {
    const int q = lane >> 4, c4 = 4 * (lane & 15);
#pragma unroll
    for (int i = 0; i < 4; ++i) { LAS unsigned char* d = scr + (8 * i + 2 * q) * 2; const v4u a = v[8 + 2 * i], b2 = v[8 + 2 * i + 1];
        *(LAS unsigned*)(d + (c4 + 0) * 80) = cvtpk(u2f(a.x) * c.scale, u2f(b2.x) * c.scale);
        *(LAS unsigned*)(d + (c4 + 1) * 80) = cvtpk(u2f(a.y) * c.scale, u2f(b2.y) * c.scale);
        *(LAS unsigned*)(d + (c4 + 2) * 80) = cvtpk(u2f(a.z) * c.scale, u2f(b2.z) * c.scale);
        *(LAS unsigned*)(d + (c4 + 3) * 80) = cvtpk(u2f(a.w) * c.scale, u2f(b2.w) * c.scale); }
    LDS_WAIT(); asm volatile("" ::: "memory");
    const int ch = lane & 3;
#pragma unroll
    for (int j = 0; j < 4; ++j) { const int n = (lane >> 2) + 16 * j; const v4u o = *(const LAS v4u*)(scr + n * 80 + 16 * ch);
        *(GAS v4u*)(c.WT + (size_t)(c.orow0 + n) * c.ldk + c.k0 + 8 * ch) = o; }
    LDS_WAIT(); asm volatile("" ::: "memory");
}
__device__ __forceinline__ ConvItem ffn_item32(int l, int idx) {
    ConvItem c; const int i = l >> 1; const bool moe = (l & 1) != 0;
    const int dff = moe ? DFE : DFF, nb_gu = dff / 64, it_gu = (D / 32) * nb_gu, it_dn = (dff / 32) * (D / 64), per = 2 * it_gu + it_dn;
    const int e = idx / per, r = idx - e * per; c.ok = moe ? (e < NEXP) : (e < 1);
    const int ee = c.ok ? e : 0;
    if (r < 2 * it_gu) { const int half = r >= it_gu, it = r - half * it_gu, kb = it / nb_gu, nb = it - kb * nb_gu, n0 = 64 * nb;
        c.W = (moe ? inp(half ? 27 : 26) : inp(half ? 23 : 22)) + ((size_t)i * (moe ? NEXP : 1) + ee) * D * dff; c.N = dff; c.k0 = 32 * kb; c.n0 = n0; c.ldk = D;
        c.orow0 = 256 * (n0 >> 7) + (n0 & 127) + 128 * half; c.WT = (bf16*)(size_t)(WS_WF + (size_t)ee * 2 * dff * D * 2); }
    else { const int it = r - 2 * it_gu, kb = it / (D / 64), nb = it - kb * (D / 64);
        c.W = (moe ? inp(28) : inp(24)) + ((size_t)i * (moe ? NEXP : 1) + ee) * dff * D; c.N = D; c.k0 = 32 * kb; c.n0 = 64 * nb; c.ldk = dff; c.orow0 = 64 * nb;
        c.WT = (bf16*)(size_t)(WS_WFD + (size_t)ee * D * dff * 2); }
    return c;
}
__device__ __forceinline__ ConvItem scan_item32(int l, int idx) {
    ConvItem c = ffn_item32(l, idx);
    if (c.ok || l + 1 >= DEPTH) return c;
    const bool moe = (l & 1) != 0; const int dff = moe ? DFE : DFF; const int per = 2 * (D / 32) * (dff / 64) + (dff / 32) * (D / 64);
    int r = idx - (moe ? NEXP : 1) * per; const int L = l + 1;
    c.ok = true; c.scale = 1.0f; c.N = HW;
    if (r < 32 * 52) { const int kb = r / 52, nb = r - kb * 52; c.W = inp(1) + (size_t)L * D * 3328; c.N = 3328; c.k0 = 32 * kb; c.n0 = 64 * nb; c.ldk = D; c.orow0 = c.n0; c.WT = (bf16*)(size_t)WS_WIN; c.scale = (c.n0 < 512) ? 0.125f : 1.0f; return c; }
    r -= 32 * 52;
    if (r < 16) { c.W = inp(5) + (size_t)L * 64 * HW; c.k0 = 32 * (r >> 3); c.n0 = 64 * (r & 7); c.ldk = 64; c.orow0 = c.n0; c.WT = (bf16*)(size_t)WS_WLORA; return c; }
    r -= 16;
    if (r < 16) { c.W = inp(7) + (size_t)L * 64 * HW; c.k0 = 32 * (r >> 3); c.n0 = 64 * (r & 7); c.ldk = 64; c.orow0 = c.n0; c.WT = (bf16*)(size_t)(WS_WLORA + (size_t)512 * 64 * 2); return c; }
    r -= 16;
    if (r < 32) { c.W = inp(11) + (size_t)L * 128 * HW; c.k0 = 32 * (r >> 3); c.n0 = 64 * (r & 7); c.ldk = 128; c.orow0 = c.n0; c.WT = (bf16*)(size_t)(WS_WLORA + (size_t)2 * 512 * 64 * 2); return c; }
    r -= 32;
    if (r < 8) { c.W = inp(9) + (size_t)(L - 1) * 32 * HW; c.k0 = 0; c.n0 = 64 * r; c.ldk = 32; c.orow0 = c.n0; c.WT = (bf16*)(size_t)(WS_WLORA + ((size_t)2 * 512 * 64 + 512 * 128) * 2); return c; }
    r -= 8;
    if (r < 32 * 16) { const int kb = r >> 4, nb = r & 15; c.W = inp(17) + (size_t)L * D * D; c.N = D; c.k0 = 32 * kb; c.n0 = 64 * nb; c.ldk = D; c.orow0 = c.n0; c.WT = (bf16*)(size_t)((L & 1) ? WS_WOUT2 : WS_WOUT); return c; }
    c.ok = false; return c;
}
__device__ __forceinline__ void conv_matrix(Frame& F, const float* W, int K, int N, bf16* WT, int ldk, int row_off, int mode_half, float scale_cols_lt, float scale) {
    const int gw = F.vcu * NWAVES + F.wave, NGW = F.G * NWAVES;
    if ((K & 63) == 0 && (N & 63) == 0) {
        LAS unsigned char* scr = F.lds + F.wave * 16384;
        const int nnb = N / 64, nit = (K / 64) * nnb;
        for (int it = gw; it < nit; it += NGW) {
            const int kb = it / nnb, nb = it % nnb, n0 = 64 * nb;
            int orow0; if (mode_half < 0) orow0 = row_off + n0; else orow0 = row_off + 256 * (n0 >> 7) + (n0 & 127) + 128 * mode_half;
            const float sc = ((float)n0 < scale_cols_lt) ? scale : 1.0f;
            conv_item64(W, N, 64 * kb, n0, WT, ldk, orow0, sc, scr, F.lane);
        }
    } else {
        LAS float* scr = (LAS float*)(F.lds + F.wave * 16384);
        const int nkb = (K + 63) / 64, nnb = N / 32, nit = nkb * nnb;
        for (int it = gw; it < nit; it += NGW) {
            const int kb = it / nnb, nb = it % nnb, n0 = 32 * nb;
            int orow0; if (mode_half < 0) orow0 = row_off + n0; else orow0 = row_off + 256 * (n0 >> 7) + (n0 & 127) + 128 * mode_half;
            const float sc = ((float)n0 < scale_cols_lt) ? scale : 1.0f;
            conv_item(W, K, N, 64 * kb, n0, WT, ldk, orow0, sc, scr, F.lane);
        }
    }
}
__device__ __forceinline__ void conv_mixer_rest(Frame& F, int l) {
    bf16* WIN = (bf16*)(F.ws + WS_WIN);
    conv_matrix(F, inp(2) + (size_t)(l - 1) * D * 32, D, 32, WIN, D, 3328, -1, 0.f, 1.f);
}
__device__ __forceinline__ void conv_mixer_weights(Frame& F, int l) {
    bf16* WIN = (bf16*)(F.ws + WS_WIN); bf16* WOUT = (bf16*)(F.ws + WS_WOUT); bf16* WL = (bf16*)(F.ws + WS_WLORA);
    conv_matrix(F, inp(1) + (size_t)l * D * 3328, D, 3328, WIN, D, 0, -1, 512.f, 0.125f);
    if (l > 0) conv_matrix(F, inp(2) + (size_t)(l - 1) * D * 32, D, 32, WIN, D, 3328, -1, 0.f, 1.f);
    { const int r0 = (l > 0) ? 3360 : 3328; const size_t n16 = (size_t)(NPROJ - r0) * D * 2 / 16; GAS v4u* z = (GAS v4u*)(WIN + (size_t)r0 * D);
      for (size_t i = (size_t)F.vcu * 512 + F.tid; i < n16; i += (size_t)F.G * 512) z[i] = (v4u){0u, 0u, 0u, 0u}; }
    conv_matrix(F, inp(17) + (size_t)l * D * D, D, D, WOUT, D, 0, -1, 0.f, 1.f);
    conv_matrix(F, inp(5) + (size_t)l * 64 * HW, 64, HW, WL, 64, 0, -1, 0.f, 1.f);
    conv_matrix(F, inp(7) + (size_t)l * 64 * HW, 64, HW, WL + 512 * 64, 64, 0, -1, 0.f, 1.f);
    conv_matrix(F, inp(11) + (size_t)l * 128 * HW, 128, HW, WL + 2 * 512 * 64, 128, 0, -1, 0.f, 1.f);
    if (l > 0) conv_matrix(F, inp(9) + (size_t)(l - 1) * 32 * HW, 32, HW, WL + 2 * 512 * 64 + 512 * 128, 32, 0, -1, 0.f, 1.f);
}
__device__ __forceinline__ void conv_ffn_weights(Frame& F, int l) {
    bf16* WGU = (bf16*)(F.ws + WS_WF); bf16* WD = (bf16*)(F.ws + WS_WFD); const int i = l >> 1;
    if ((l & 1) == 0) {
        conv_matrix(F, inp(22) + (size_t)i * D * DFF, D, DFF, WGU, D, 0, 0, 0.f, 1.f);
        conv_matrix(F, inp(23) + (size_t)i * D * DFF, D, DFF, WGU, D, 0, 1, 0.f, 1.f);
        conv_matrix(F, inp(24) + (size_t)i * DFF * D, DFF, D, WD, DFF, 0, -1, 0.f, 1.f);
    } else {
        for (int e = 0; e < NEXP; ++e) {
            conv_matrix(F, inp(26) + ((size_t)i * NEXP + e) * D * DFE, D, DFE, WGU + (size_t)e * 2 * DFE * D, D, 0, 0, 0.f, 1.f);
            conv_matrix(F, inp(27) + ((size_t)i * NEXP + e) * D * DFE, D, DFE, WGU + (size_t)e * 2 * DFE * D, D, 0, 1, 0.f, 1.f);
            conv_matrix(F, inp(28) + ((size_t)i * NEXP + e) * DFE * D, DFE, D, WD + (size_t)e * D * DFE, DFE, 0, -1, 0.f, 1.f);
        }
    }
}
__device__ __forceinline__ void conv_x(Frame& F) {
    const GAS f32x4* x = (const GAS f32x4*)inp(0); GAS u32x2* o = (GAS u32x2*)(F.ws + WS_XB);
    { const size_t n4 = (size_t)M * D / 4, st = (size_t)F.G * 512; size_t i = (size_t)F.vcu * 512 + F.tid;
      for (; i + 7 * st < n4; i += 8 * st) { f32x4 v[8];
#pragma unroll
          for (int u = 0; u < 8; ++u) v[u] = x[i + u * st];
#pragma unroll
          for (int u = 0; u < 8; ++u) { u32x2 w; w.x = cvtpk(v[u].x, v[u].y); w.y = cvtpk(v[u].z, v[u].w); o[i + u * st] = w; } }
      for (; i < n4; i += st) { const f32x4 v = x[i]; u32x2 w; w.x = cvtpk(v.x, v.y); w.y = cvtpk(v.z, v.w); o[i] = w; } }
}

struct EpiSwiglu {
    static constexpr bool PERM = true, AFTER_DRAIN = false;
    bf16* O; int ldc;
    __device__ __forceinline__ void operator()(const pg8::f32x4 (&acc)[2][2][4][2], const pg8::Unit& u, int wr, int wc, int fr, int fq) const {
        const int row0 = u.pm * 256 + wr * 64 + fr, col0 = u.pn * 128 + wc * 32 + 8 * fq;
#pragma unroll
        for (int ai = 0; ai < 2; ++ai)
#pragma unroll
            for (int m = 0; m < 4; ++m) {
                bf16* rowp = O + (size_t)(row0 + ai * 128 + m * 16) * ldc + col0; float h[8];
#pragma unroll
                for (int n = 0; n < 2; ++n)
#pragma unroll
                    for (int i = 0; i < 4; ++i) { const float gt = acc[ai][0][m][n][i], up = acc[ai][1][m][n][i]; h[4 * n + i] = gt * fast_sigmoid(gt) * up; }
                v4u w; w.x = cvtpk(h[0], h[1]); w.y = cvtpk(h[2], h[3]); w.z = cvtpk(h[4], h[5]); w.w = cvtpk(h[6], h[7]);
                *(v4u*)rowp = w;
            }
    }
};
struct EpiMoeDown {
    static constexpr bool PERM = true, AFTER_DRAIN = false;
    bf16* O; const int* rowdst; const float* rowgate; float* PT; int slot0;
    __device__ __forceinline__ void operator()(const pg8::f32x4 (&acc)[2][2][4][2], const pg8::Unit& u, int wr, int wc, int fr, int fq) const {
        const int row0 = u.pm * 256 + wr * 64 + fr, col0 = u.pn * 256 + wc * 32 + 8 * fq;
        if (u.q > 0) {
            float* pb = PT + (size_t)(u.q - 1) * PT_TILES * 256 * D;
#pragma unroll
            for (int ai = 0; ai < 2; ++ai)
#pragma unroll
                for (int m = 0; m < 4; ++m) { const int slot = row0 + ai * 128 + m * 16; const float gt = rowgate[slot]; float* rp = pb + (size_t)(slot - slot0) * D + col0;
#pragma unroll
                    for (int bj = 0; bj < 2; ++bj) { *(pg8::f32x4*)(rp + bj * 128) = acc[ai][bj][m][0] * gt; *(pg8::f32x4*)(rp + bj * 128 + 4) = acc[ai][bj][m][1] * gt; } }
            return;
        }
#pragma unroll
        for (int ai = 0; ai < 2; ++ai)
#pragma unroll
            for (int m = 0; m < 4; ++m) {
                const int slot = row0 + ai * 128 + m * 16; const int dst = rowdst[slot]; const float gt = rowgate[slot];
                if (dst >= 0) { bf16* rowp = O + (size_t)dst * D + col0;
#pragma unroll
                    for (int bj = 0; bj < 2; ++bj) { const pg8::f32x4 v0 = acc[ai][bj][m][0] * gt, v1 = acc[ai][bj][m][1] * gt;
                        v4u w; w.x = cvtpk(v0[0], v0[1]); w.y = cvtpk(v0[2], v0[3]); w.z = cvtpk(v1[0], v1[1]); w.w = cvtpk(v1[2], v1[3]);
                        *(v4u*)(rowp + bj * 128) = w; } }
            }
    }
};
struct NaiveOrder {
    int nN, G, c, nwg;
    __device__ __forceinline__ void init(int M_, int N_, int G_, int c_) { nN = N_ / 256; nwg = (M_ / 256) * nN; G = G_; c = c_; }
    __device__ __forceinline__ bool next(int i, pg8::Unit& u) const { const long L = (long)i * G + c; if (L >= nwg) return false; u.pm = (int)(L / nN); u.pn = (int)(L % nN); u.bofs = 0u; u.kofs = 0u; u.nt = 0; u.q = 0; return true; }
    __device__ __forceinline__ void a_ready(const pg8::Unit&) const {}
    __device__ __forceinline__ void done(const pg8::Unit&) const {}
};
struct TailPlan { int nMt, Rfull, T, S, pm0; };
__device__ __forceinline__ TailPlan tail_plan(const unsigned* cnt, int nN, int G, bool split) {
    TailPlan p; int t = 0;
#pragma unroll
    for (int e = 0; e < 8; ++e) t += __builtin_amdgcn_readfirstlane((int)((cnt[e] + 255u) >> 8));
    p.nMt = t; const int U = t * nN; p.Rfull = U / G; p.T = U - p.Rfull * G; p.pm0 = (p.Rfull * G) / nN;
    p.S = 1; if (split && p.T > 0 && p.T <= 4 * PT_TILES && ((p.Rfull * G) % nN) == 0) p.S = (p.T * 4 <= G) ? 4 : ((p.T * 2 <= G) ? 2 : 1);
    return p;
}
struct GroupedOrder {
    int nN, G, c, nMt; int t1, t2, t3, t4, t5, t6, t7; unsigned estride; int Rfull, T, S, ntfull;
    __device__ __forceinline__ void init(const unsigned* cnt, int nN_, int G_, int c_, unsigned estride_, bool split = false, int K = 0) {
        nN = nN_; G = G_; c = c_; estride = estride_;
#define RFL(x) __builtin_amdgcn_readfirstlane((int)(x))
        int t = 0; t += RFL((cnt[0] + 255u) >> 8); t1 = t; t += RFL((cnt[1] + 255u) >> 8); t2 = t; t += RFL((cnt[2] + 255u) >> 8); t3 = t; t += RFL((cnt[3] + 255u) >> 8); t4 = t;
        t += RFL((cnt[4] + 255u) >> 8); t5 = t; t += RFL((cnt[5] + 255u) >> 8); t6 = t; t += RFL((cnt[6] + 255u) >> 8); t7 = t; t += RFL((cnt[7] + 255u) >> 8); nMt = t;
        const TailPlan p = tail_plan(cnt, nN, G, split); Rfull = p.Rfull; T = p.T; S = p.S; ntfull = K / 64;
    }
    __device__ __forceinline__ bool next(int i, pg8::Unit& u) const {
        int Lu; u.kofs = 0u; u.nt = 0; u.q = 0;
        if (S == 1) { const long L = (long)i * G + c; if (L >= (long)nMt * nN) return false; Lu = (int)L; }
        else { if (i < Rfull) Lu = i * G + c; else if (i == Rfull) { if (c >= T * S) return false; Lu = Rfull * G + c / S; const int q = c % S; u.q = q; u.nt = ntfull / S; u.kofs = (unsigned)(q * (ntfull / S) * 128); } else return false; }
        const int pm = Lu / nN, pn = Lu % nN;
        const int e = (pm >= t1) + (pm >= t2) + (pm >= t3) + (pm >= t4) + (pm >= t5) + (pm >= t6) + (pm >= t7);
        u.pm = pm; u.pn = pn; u.bofs = (unsigned)e * estride; return true;
    }
    __device__ __forceinline__ void a_ready(const pg8::Unit&) const {}
    __device__ __forceinline__ void done(const pg8::Unit&) const {}
};

constexpr int PR_ROWB = 3648, PR_PIECES = 17 * (PR_ROWB / 16), PR_BUF = 62464, PR_DUMMY = 2 * PR_BUF, PR_AOP = 132096;
__device__ __forceinline__ v4u prep_aop(const LAS unsigned char* buf, int c, int g, bool first, int kb, const float* mu, const float* muv) {
    const LAS unsigned char* pc = buf + (c + 1) * 3648 + 3072 + 16 * g + 64 * kb;
    const v4u cu = *(const LAS v4u*)(pc); v4u pv = *(const LAS v4u*)(pc - 3648); if (first) pv = (v4u){0u, 0u, 0u, 0u};
    const float* mp = (kb < 8) ? (mu + 1536 + 32 * kb + 8 * g) : (muv + 8 * g);
    const f32x4 m0v = *(const f32x4*)mp, m1v = *(const f32x4*)(mp + 4);
    float v[8] = {bflo(cu.x), bfhi(cu.x), bflo(cu.y), bfhi(cu.y), bflo(cu.z), bfhi(cu.z), bflo(cu.w), bfhi(cu.w)};
    const float p[8] = {bflo(pv.x), bfhi(pv.x), bflo(pv.y), bfhi(pv.y), bflo(pv.z), bfhi(pv.z), bflo(pv.w), bfhi(pv.w)};
#pragma unroll
    for (int j = 0; j < 8; ++j) { const float mm = (j < 4) ? m0v[j & 3] : m1v[j & 3]; v[j] = v[j] + (p[j] - v[j]) * mm; }
    if (kb < 2) {
#pragma unroll
        for (int j = 0; j < 8; ++j) v[j] = fast_tanh(v[j]);
    } else if (kb >= 4 && kb < 8) {
#pragma unroll
        for (int j = 0; j < 8; ++j) v[j] = fast_sigmoid(v[j]);
    }
    v4u o; o.x = cvtpk(v[0], v[1]); o.y = cvtpk(v[2], v[3]); o.z = cvtpk(v[4], v[5]); o.w = cvtpk(v[6], v[7]);
    return o;
}
__device__ __forceinline__ void prep_issue(const bf16* PROJ, int tile, LAS unsigned char* buf, LAS unsigned char* dummy, int wave, int lane) {
    const int tok0 = tile * 16;
#pragma unroll
    for (int i = 0; i < 8; ++i) {
        const int ins = wave + 8 * i; int p = ins * 64 + lane; if (p > PR_PIECES - 1) p = PR_PIECES - 1;
        const int r = p / (PR_ROWB / 16), cp = p - r * (PR_ROWB / 16); int row = tok0 - 1 + r; if (row < 0) row = 0;
        const unsigned char* src = (const unsigned char*)PROJ + (size_t)row * (NPROJ * 2) + 3072 + 16 * cp;
        LAS unsigned char* dst = (ins < 61) ? buf + ins * 1024 : dummy;
        __builtin_amdgcn_global_load_lds((const unsigned*)src, (LAS unsigned*)dst, 16, 0, 0);
    }
}
template <bool HASV>
__device__ __forceinline__ void prep_phase(Frame& F, int l) {
    const bf16* PROJ = (const bf16*)(F.ws + WS_PROJ); unsigned char* SC = F.ws + WS_SCANIN; bf16* GB = (bf16*)(F.ws + WS_G); bf16* VF = (bf16*)(F.ws + WS_VF); bf16* BON = (bf16*)(F.ws + WS_BONUS);
    const bf16* WL = (const bf16*)(F.ws + WS_WLORA);
    const float* mu = inp(3) + (size_t)l * 1792; const float* muv = inp(4) + (size_t)(HASV ? l - 1 : 0) * 32;
    const int lane = F.lane, g = lane >> 4, c = lane & 15;
    const int h = F.wave; const int colh = 64 * h + 4 * c;
    const f32x4 mu_r = *(const f32x4*)(mu + colh), mu_k = *(const f32x4*)(mu + 512 + colh), mu_v = *(const f32x4*)(mu + 1024 + colh);
    const f32x4 dbase = *(const f32x4*)(inp(6) + (size_t)l * HW + colh), abase = *(const f32x4*)(inp(8) + (size_t)l * HW + colh);
    const f32x4 vbase = HASV ? *(const f32x4*)(inp(10) + (size_t)(l - 1) * HW + colh) : (f32x4){0.f, 0.f, 0.f, 0.f};
    const f32x4 kkp = *(const f32x4*)(inp(12) + (size_t)l * HW + colh), kap = *(const f32x4*)(inp(13) + (size_t)l * HW + colh), rkp = *(const f32x4*)(inp(14) + (size_t)l * HW + colh);
    constexpr int NKB = HASV ? 9 : 8;
    LAS unsigned char* dummy = F.lds + PR_DUMMY;
    int tile = F.vcu;
    if (tile < M / 16) prep_issue(PROJ, tile, F.lds, dummy, F.wave, lane);
    for (int it = 0; tile < M / 16; tile += F.G, ++it) {
        const int tok0 = tile * 16;
        LAS unsigned char* buf = F.lds + (it & 1) * PR_BUF;
        if (tile + F.G < M / 16) { prep_issue(PROJ, tile + F.G, F.lds + ((it + 1) & 1) * PR_BUF, dummy, F.wave, lane); asm volatile("s_waitcnt vmcnt(8)" ::: "memory"); }
        else asm volatile("s_waitcnt vmcnt(0)" ::: "memory");
        __builtin_amdgcn_s_barrier(); asm volatile("" ::: "memory");
        const int m0 = tok0 + 4 * g; const bool first0 = (m0 & (SEQ - 1)) == 0;
        u32x2 Rr[5], Kr[5], Vr[5], vfr[4];
#pragma unroll
        for (int e = 0; e < 5; ++e) { const LAS unsigned char* p = buf + (4 * g + e) * PR_ROWB + 2 * colh;
            Rr[e] = *(const LAS u32x2*)(p); Kr[e] = *(const LAS u32x2*)(p + 1024); Vr[e] = *(const LAS u32x2*)(p + 2048); }
        if (HASV) {
#pragma unroll
            for (int e = 0; e < 4; ++e) vfr[e] = *(const u32x2*)(VF + (size_t)(m0 + e) * HW + colh); }
        if (first0) { Rr[0] = (u32x2){0u, 0u}; Kr[0] = (u32x2){0u, 0u}; Vr[0] = (u32x2){0u, 0u}; }
        pg8::bf16x8 Aop[NKB];
        { const bool first = ((tok0 + c) & (SEQ - 1)) == 0; LAS unsigned char* aop = F.lds + PR_AOP;
          *(LAS v4u*)(aop + h * 1024 + lane * 16) = prep_aop(buf, c, g, first, h, mu, muv);
          if (HASV && h == 0) *(LAS v4u*)(aop + 8 * 1024 + lane * 16) = prep_aop(buf, c, g, first, 8, mu, muv);
          asm volatile("s_waitcnt lgkmcnt(0)" ::: "memory"); __builtin_amdgcn_s_barrier(); asm volatile("" ::: "memory");
#pragma unroll
          for (int kb = 0; kb < NKB; ++kb) Aop[kb] = *(const LAS pg8::bf16x8*)(aop + kb * 1024 + lane * 16);
        }
        const size_t srow = ((size_t)((m0 >> 12) * 8 + h) * SEQ + (m0 & (SEQ - 1))) * SC_ROW;
        const pg8::f32x4 z4 = (pg8::f32x4){0.f, 0.f, 0.f, 0.f};
        { pg8::f32x4 aw[4];
#pragma unroll
          for (int nt = 0; nt < 4; ++nt) { aw[nt] = z4;
#pragma unroll
              for (int kb = 0; kb < 2; ++kb) { const pg8::bf16x8 b = *(const pg8::bf16x8*)(WL + (size_t)(colh + nt) * 64 + 32 * kb + 8 * g); aw[nt] = __builtin_amdgcn_mfma_f32_16x16x32_bf16(Aop[kb], b, aw[nt], 0, 0, 0); } }
#pragma unroll
          for (int e = 0; e < 4; ++e) { f32x4 w4;
#pragma unroll
              for (int nt = 0; nt < 4; ++nt) w4[nt] = fast_exp(-0.6065306597126334f * fast_sigmoid(dbase[nt] + aw[nt][e]));
              { u32x2 uo; uo.x = cvtpk(1.0f - w4[0], 1.0f - w4[1]); uo.y = cvtpk(1.0f - w4[2], 1.0f - w4[3]);
                __builtin_nontemporal_store(uo, (u32x2*)(SC + srow + (size_t)e * SC_ROW + 16 * (c & 7) + 8 * (c >> 3))); } } }
        { pg8::f32x4 ag[4];
#pragma unroll
          for (int nt = 0; nt < 4; ++nt) { ag[nt] = z4;
#pragma unroll
              for (int kb = 0; kb < 4; ++kb) { const pg8::bf16x8 b = *(const pg8::bf16x8*)(WL + 2 * 512 * 64 + (size_t)(colh + nt) * 128 + 32 * kb + 8 * g); ag[nt] = __builtin_amdgcn_mfma_f32_16x16x32_bf16(Aop[4 + kb], b, ag[nt], 0, 0, 0); } }
#pragma unroll
          for (int e = 0; e < 4; ++e) { u32x2 go; go.x = cvtpk(ag[0][e], ag[1][e]); go.y = cvtpk(ag[2][e], ag[3][e]); __builtin_nontemporal_store(go, (u32x2*)(GB + (size_t)(m0 + e) * HW + colh)); } }
        f32x4 rkeep[4], vkeep[4];
        { pg8::f32x4 av[4];
          if (HASV) {
#pragma unroll
              for (int nt = 0; nt < 4; ++nt) { const pg8::bf16x8 b = *(const pg8::bf16x8*)(WL + 2 * 512 * 64 + 512 * 128 + (size_t)(colh + nt) * 32 + 8 * g); av[nt] = __builtin_amdgcn_mfma_f32_16x16x32_bf16(Aop[NKB - 1], b, z4, 0, 0, 0); } }
#pragma unroll
          for (int e = 0; e < 4; ++e) {
              const float cv[4] = {bflo(Vr[e + 1].x), bfhi(Vr[e + 1].x), bflo(Vr[e + 1].y), bfhi(Vr[e + 1].y)}, pv[4] = {bflo(Vr[e].x), bfhi(Vr[e].x), bflo(Vr[e].y), bfhi(Vr[e].y)};
              const float cr[4] = {bflo(Rr[e + 1].x), bfhi(Rr[e + 1].x), bflo(Rr[e + 1].y), bfhi(Rr[e + 1].y)}, pr[4] = {bflo(Rr[e].x), bfhi(Rr[e].x), bflo(Rr[e].y), bfhi(Rr[e].y)};
              f32x4 v2, r2;
#pragma unroll
              for (int nt = 0; nt < 4; ++nt) { const float vv = cv[nt] + (pv[nt] - cv[nt]) * mu_v[nt]; r2[nt] = cr[nt] + (pr[nt] - cr[nt]) * mu_r[nt];
                  if (HASV) { const float vf = (nt & 1) ? bfhi(nt < 2 ? vfr[e].x : vfr[e].y) : bflo(nt < 2 ? vfr[e].x : vfr[e].y); v2[nt] = vv + (vf - vv) * fast_sigmoid(vbase[nt] + av[nt][e]); } else v2[nt] = vv; }
              { u32x2 ro; ro.x = cvtpk(r2[0], r2[1]); ro.y = cvtpk(r2[2], r2[3]); u32x2 vo2; vo2.x = cvtpk(v2[0], v2[1]); vo2.y = cvtpk(v2[2], v2[3]);
                __builtin_nontemporal_store(ro, (u32x2*)(SC + srow + (size_t)e * SC_ROW + 512 + 16 * (c & 7) + 8 * (c >> 3))); __builtin_nontemporal_store(vo2, (u32x2*)(SC + srow + (size_t)e * SC_ROW + 640 + 16 * (c & 7) + 8 * (c >> 3))); }
              rkeep[e] = r2; vkeep[e] = v2;
              if (!HASV) { u32x2 vo; vo.x = cvtpk(v2[0], v2[1]); vo.y = cvtpk(v2[2], v2[3]); *(u32x2*)(VF + (size_t)(m0 + e) * HW + colh) = vo; }
          } }
        { pg8::f32x4 aa[4];
#pragma unroll
          for (int nt = 0; nt < 4; ++nt) { aa[nt] = z4;
#pragma unroll
              for (int kb = 0; kb < 2; ++kb) { const pg8::bf16x8 b = *(const pg8::bf16x8*)(WL + 512 * 64 + (size_t)(colh + nt) * 64 + 32 * kb + 8 * g); aa[nt] = __builtin_amdgcn_mfma_f32_16x16x32_bf16(Aop[2 + kb], b, aa[nt], 0, 0, 0); } }
#pragma unroll
          for (int e = 0; e < 4; ++e) {
              const float ck[4] = {bflo(Kr[e + 1].x), bfhi(Kr[e + 1].x), bflo(Kr[e + 1].y), bfhi(Kr[e + 1].y)}, pk[4] = {bflo(Kr[e].x), bfhi(Kr[e].x), bflo(Kr[e].y), bfhi(Kr[e].y)};
              float kx[4], kr[4], a4[4]; float ss = 0.f;
#pragma unroll
              for (int nt = 0; nt < 4; ++nt) { kx[nt] = ck[nt] + (pk[nt] - ck[nt]) * mu_k[nt]; kr[nt] = kx[nt] * kkp[nt]; ss += kr[nt] * kr[nt]; a4[nt] = fast_sigmoid(abase[nt] + aa[nt][e]); }
              ss = red16(ss);
              const float inv = fminf(__builtin_amdgcn_rsqf(ss), 1e12f);
              f32x4 kn, bb, k2;
#pragma unroll
              for (int nt = 0; nt < 4; ++nt) { kn[nt] = kr[nt] * inv; bb[nt] = kn[nt] * a4[nt]; k2[nt] = kx[nt] * (1.0f + (a4[nt] - 1.0f) * kap[nt]); }
              { u32x2 bo2; bo2.x = cvtpk(bb[0], bb[1]); bo2.y = cvtpk(bb[2], bb[3]); __builtin_nontemporal_store(bo2, (u32x2*)(SC + srow + (size_t)e * SC_ROW + 128 + 16 * (c & 7) + 8 * (c >> 3))); }
              { u32x2 ko; ko.x = cvtpk(kn[0], kn[1]); ko.y = cvtpk(kn[2], kn[3]); u32x2 k2o; k2o.x = cvtpk(k2[0], k2[1]); k2o.y = cvtpk(k2[2], k2[3]);
                __builtin_nontemporal_store(ko, (u32x2*)(SC + srow + (size_t)e * SC_ROW + 256 + 16 * (c & 7) + 8 * (c >> 3))); __builtin_nontemporal_store(k2o, (u32x2*)(SC + srow + (size_t)e * SC_ROW + 384 + 16 * (c & 7) + 8 * (c >> 3))); }
              { float bs = (rkeep[e][0] * k2[0] * rkp[0] + rkeep[e][1] * k2[1] * rkp[1]) + (rkeep[e][2] * k2[2] * rkp[2] + rkeep[e][3] * k2[3] * rkp[3]); bs = red16(bs);
                if (c == 0) ((float*)BON)[(size_t)(m0 + e) * 8 + h] = bs; }
          } }
        asm volatile("s_waitcnt lgkmcnt(0)" ::: "memory"); __builtin_amdgcn_s_barrier(); asm volatile("" ::: "memory");
    }
    asm volatile("s_waitcnt vmcnt(0)" ::: "memory"); __syncthreads();
}

constexpr int SC_T = 16, SC_NCH = SEQ / SC_T, SC_BUF = SC_T * 384 * 4, SC_YOFF = 4 * SC_BUF, SC_YBUF = SC_T * 16 * 4, SC_CONV = 104448;
__device__ __forceinline__ void scan_put(LAS unsigned char* dst_step, int p, v4u x) {
    if (p < 32) { *(LAS v4u*)(dst_step + ((p < 16) ? 16 * p : 512 + 16 * (p - 16))) = x; }
    else { const int qq = p - 32, vs = qq >> 3; const int off = ((vs == 0) ? 256 : (vs == 1) ? 768 : (vs == 2) ? 1024 : 1280) + 32 * (qq & 7);
        v4u lo, hi; lo.x = x.x << 16; lo.y = x.x & 0xffff0000u; lo.z = x.y << 16; lo.w = x.y & 0xffff0000u; hi.x = x.z << 16; hi.y = x.z & 0xffff0000u; hi.z = x.w << 16; hi.w = x.w & 0xffff0000u;
        *(LAS v4u*)(dst_step + off) = lo; *(LAS v4u*)(dst_step + off + 16) = hi; }
}
__device__ __forceinline__ void scan_put_bf(LAS unsigned char* dst, v4u x) {
    v4u lo, hi; lo.x = x.x << 16; lo.y = x.x & 0xffff0000u; lo.z = x.y << 16; lo.w = x.y & 0xffff0000u; hi.x = x.z << 16; hi.y = x.z & 0xffff0000u; hi.z = x.w << 16; hi.w = x.w & 0xffff0000u;
    *(LAS v4u*)(dst) = lo; *(LAS v4u*)(dst + 128) = hi;
}
__device__ __forceinline__ void scan_phase(Frame& F, int l) {
    const unsigned char* SC = F.ws + WS_SCANIN; bf16* YS = (bf16*)(F.ws + WS_YS);
    const int lane = F.lane, w = F.wave;
    for (int unit = F.vcu; unit < 256; unit += F.G) {
        const int bh = unit >> 2, q = unit & 3, b = bh >> 3, h = bh & 7;
        const GAS v4u* src = (const GAS v4u*)(SC + (size_t)bh * SEQ * SC_ROW);
        const int hw = w - 4;
        int so_[3], lo_[3];
#pragma unroll
        for (int i = 0; i < 3; ++i) { const int qq = lane + 64 * i, st = 4 * hw + qq / 48, p = qq % 48, vid = p >> 3, sub = p & 7;
            so_[i] = st * 48 + p;
            lo_[i] = st * 1536 + (vid == 0 ? 0 : vid == 1 ? 512 : vid == 2 ? 256 : vid == 3 ? 768 : vid == 4 ? 1024 : 1280) + 16 * sub; }
        const GAS v4u* srcl = src;
#define SCAN_SRC(chunk, i) srcl[(size_t)(chunk) * (SC_T * 48) + so_[i]]
#define SCAN_PUT(dstbase, i, x) scan_put_bf((dstbase) + lo_[i], x)
        v4u R[16]; int cidx = -1;
        LAS unsigned char* cscr = F.lds + SC_CONV + (w & 3) * 5120;
        __syncthreads();
        if (w >= 4) {
#pragma unroll
            for (int i = 0; i < 3; ++i) { R[i] = SCAN_SRC(0, i); R[4 + i] = SCAN_SRC(1, i); }
#pragma unroll
            for (int i = 0; i < 3; ++i) { SCAN_PUT(F.lds, i, R[i]); SCAN_PUT(F.lds + SC_BUF, i, R[4 + i]); }
#pragma unroll
            for (int i = 0; i < 3; ++i) { R[i] = SCAN_SRC(2, i); R[4 + i] = SCAN_SRC(3, i); }
        }
        __syncthreads();
        typedef float f32x2v __attribute__((ext_vector_type(2)));
        f32x2v S01 = (f32x2v){0.f, 0.f}, S23 = (f32x2v){0.f, 0.f};
        const int i4 = lane >> 4, j = lane & 15;
        if (w < 4) __builtin_amdgcn_s_setprio(3);
        for (int ch4 = 0; ch4 < SC_NCH; ch4 += 4) {
#pragma unroll
            for (int kp = 0; kp < 4; kp += 2) {
                if (w >= 4) {
#pragma unroll
                  for (int k = kp; k < kp + 2; ++k) { const int ch = ch4 + k;
                    if (ch + 2 < SC_NCH) { LAS unsigned char* dst = F.lds + ((ch + 2) & 3) * SC_BUF;
#pragma unroll
                        for (int i = 0; i < 3; ++i) SCAN_PUT(dst, i, R[4 * (k & 1) + i]); }
                    if (ch + 4 < SC_NCH) {
#pragma unroll
                        for (int i = 0; i < 3; ++i) R[4 * (k & 1) + i] = SCAN_SRC(ch + 4, i); }
                    if (ch > 1 && hw == (k & 3)) { const int t = lane >> 2, part = lane & 3;
                        const f32x4 y = *(const LAS f32x4*)(F.lds + SC_YOFF + ((ch - 2) & 3) * SC_YBUF + (t * 16 + 4 * part) * 4);
                        u32x2 yo; yo.x = cvtpk(y.x, y.y); yo.y = cvtpk(y.z, y.w);
                        *(GAS u32x2*)(YS + ((size_t)b * SEQ + (ch - 2) * SC_T + t) * HW + 64 * h + 16 * q + 4 * part) = yo; }
                    if (((hw + 2) & 3) == k) { if (cidx >= 0) { ConvItem ci = scan_item32(l, cidx); ci.WT = (bf16*)(F.ws + (size_t)ci.WT); conv_item32_finish(ci, lane, R, cscr); } cidx = -1; }
                    if (hw == k) { const int idx = (ch4 + hw) * F.G + F.vcu; ConvItem ci = scan_item32(l, idx); if (ci.ok) { conv_item32_load(ci, lane, R); cidx = idx; } }
                  }
                } else {
                  f32x4 o0w = {0.f, 0.f, 0.f, 0.f}, o0kk = o0w, o0b = o0w, o0k = o0w, o0r = o0w, o1w = o0w, o1kk = o0w, o1b = o0w, o1k = o0w, o1r = o0w; float o0v = 0.f, o1v = 0.f;
#pragma unroll
                  for (int k = kp; k < kp + 2; ++k) { const int ch = ch4 + k;
                    const LAS unsigned char* buf = F.lds + (ch & 3) * SC_BUF + 16 * j; LAS float* yb = (LAS float*)(F.lds + SC_YOFF + (ch & 3) * SC_YBUF) + 4 * w + i4;
                    const LAS unsigned char* vb = F.lds + (ch & 3) * SC_BUF + 1280 + (16 * q + 4 * w + i4) * 4;
#define SC_LD(o, p_, v_) do { const LAS unsigned char* p__ = (p_); o##w = *(const LAS f32x4*)(p__); o##kk = *(const LAS f32x4*)(p__ + 256); o##b = *(const LAS f32x4*)(p__ + 512); o##k = *(const LAS f32x4*)(p__ + 768); \
                        o##r = *(const LAS f32x4*)(p__ + 1024); o##v = *(const LAS float*)(v_); } while (0)
                    if (!(k & 1)) { SC_LD(o0, buf, vb); SC_LD(o1, buf + 1536, vb + 1536); }
                    float v8[SC_T / 2], pyl = 0.f; const bool b0 = (j & 1) != 0;
#pragma unroll
                    for (int t = 0; t < SC_T; ++t) {
                        f32x4 o2w = o1w, o2kk = o1kk, o2b = o1b, o2k = o1k, o2r = o1r; float o2v = o1v;
                        if (t + 2 < SC_T) SC_LD(o2, buf + (t + 2) * 1536, vb + (t + 2) * 1536);
                        else if (!(k & 1)) { const int no = (((ch + 1) & 3) - (ch & 3)) * SC_BUF + (t + 2 - SC_T) * 1536; SC_LD(o2, buf + no, vb + no); }
                        __builtin_amdgcn_sched_barrier(0x0006);
                        const f32x2v pa2 = S01 * (f32x2v){o0kk.x, o0kk.y} + S23 * (f32x2v){o0kk.z, o0kk.w};
                        const float sa = -red16(pa2.x + pa2.y);
                        S01 = ((S01 - S01 * (f32x2v){o0w.x, o0w.y}) + (f32x2v){o0k.x, o0k.y} * o0v) + (f32x2v){o0b.x, o0b.y} * sa;
                        S23 = ((S23 - S23 * (f32x2v){o0w.z, o0w.w}) + (f32x2v){o0k.z, o0k.w} * o0v) + (f32x2v){o0b.z, o0b.w} * sa;
                        const f32x2v py2 = S01 * (f32x2v){o0r.x, o0r.y} + S23 * (f32x2v){o0r.z, o0r.w};
                        { const float pyt = py2.x + py2.y;
                          if (t & 1) { const float keep = b0 ? pyt : pyl, send = b0 ? pyl : pyt; v8[t >> 1] = keep + dppf<0xB1>(send); } else pyl = pyt; }
                        o0w = o1w; o0kk = o1kk; o0b = o1b; o0k = o1k; o0r = o1r; o0v = o1v;
                        o1w = o2w; o1kk = o2kk; o1b = o2b; o1k = o2k; o1r = o2r; o1v = o2v;
                    }
#undef SC_LD
                    { const bool b1 = (j & 2) != 0, b2 = (j & 4) != 0, b3 = (j & 8) != 0;
                      float v4[4], v2[2];
#pragma unroll
                      for (int i = 0; i < 4; ++i) { const float keep = b1 ? v8[2 * i + 1] : v8[2 * i], send = b1 ? v8[2 * i] : v8[2 * i + 1]; v4[i] = keep + dppf<0x4E>(send); }
#pragma unroll
                      for (int i = 0; i < 2; ++i) { const float keep = b2 ? v4[2 * i + 1] : v4[2 * i], send = b2 ? v4[2 * i] : v4[2 * i + 1];
                          v2[i] = keep + dppf<0x1B>(dppf<0x141>(send)); }
                      const float keep = b3 ? v2[1] : v2[0], send = b3 ? v2[0] : v2[1];
                      yb[j * 16] = keep + dppf<0x141>(dppf<0x140>(send));
                    }
                  }
                }
                __syncthreads();
            }
        }
        __builtin_amdgcn_s_setprio(0);
        if (w >= 4 && cidx >= 0) { ConvItem ci = scan_item32(l, cidx); ci.WT = (bf16*)(F.ws + (size_t)ci.WT); conv_item32_finish(ci, lane, R, cscr); cidx = -1; }
        if (w == 4) { const int t = lane >> 2, part = lane & 3;
#pragma unroll
            for (int cc = SC_NCH - 2; cc < SC_NCH; ++cc) {
                const f32x4 y = *(const LAS f32x4*)(F.lds + SC_YOFF + (cc & 3) * SC_YBUF + (t * 16 + 4 * part) * 4);
                u32x2 yo; yo.x = cvtpk(y.x, y.y); yo.y = cvtpk(y.z, y.w);
                *(GAS u32x2*)(YS + ((size_t)b * SEQ + cc * SC_T + t) * HW + 64 * h + 16 * q + 4 * part) = yo; } }
    }
}

constexpr int AT_PITCH = 144, AT_KOFF = 0, AT_VOFF = 40960;
struct AttnUnit { int p, dil, n, cls, b, h; };
__device__ __forceinline__ AttnUnit attn_decode(int u) { AttnUnit a; a.p = u >> 11; const int r = u & 2047; a.dil = 1 << (2 * a.p); const int nb = 32 >> (2 * a.p);
    a.n = r % nb; a.cls = (r / nb) % a.dil; const int bh = r >> 5; a.b = bh >> 3; a.h = bh & 7; return a; }
__device__ __forceinline__ void attn_load(const bf16* PROJ, const AttnUnit& a, int tid, int w, int g, int c16, v4u (&kq)[4], v4u (&vq)[4], pg8::bf16x8 (&qf)[2]) {
    const int row = tid >> 1, half = tid & 1; const int idx = 128 * (a.n - 1) + row;
    const int idc = idx < 0 ? 0 : idx;
    const bf16* kp = PROJ + ((size_t)a.b * SEQ + (size_t)idc * a.dil + a.cls) * NPROJ + 512 + 64 * a.h + 32 * half;
#pragma unroll
    for (int i = 0; i < 4; ++i) { kq[i] = *(const v4u*)(kp + 8 * i); vq[i] = *(const v4u*)(kp + 512 + 8 * i); }
    if (idx < 0) {
#pragma unroll
        for (int i = 0; i < 4; ++i) { kq[i] = (v4u){0u, 0u, 0u, 0u}; vq[i] = (v4u){0u, 0u, 0u, 0u}; } }
    const int qidx = 128 * a.n + 16 * w + c16; const size_t mq = (size_t)a.b * SEQ + (size_t)qidx * a.dil + a.cls;
    const bf16* qp = PROJ + mq * NPROJ + 64 * a.h + 8 * g; qf[0] = *(const pg8::bf16x8*)qp; qf[1] = *(const pg8::bf16x8*)(qp + 32);
}
__device__ __forceinline__ void attn_phase(Frame& F) {
    const bf16* PROJ = (const bf16*)(F.ws + WS_PROJ); unsigned char* PB = F.ws + WS_PROJ;
    const int lane = F.lane, w = F.wave, g = lane >> 4, c16 = lane & 15, tid = F.tid;
    LAS unsigned char* Ks = F.lds + AT_KOFF; LAS unsigned char* Vs = F.lds + AT_VOFF;
    __syncthreads();
    for (int i = tid; i < 16 * AT_PITCH / 4; i += 512) { ((LAS unsigned*)(Ks + 256 * AT_PITCH))[i] = 0u; ((LAS unsigned*)(Vs + 256 * AT_PITCH))[i] = 0u; }
    v4u kq[2][4], vq[2][4]; pg8::bf16x8 qn[2][2];
    const int u0 = F.vcu;
    if (u0 < 3 * 2048) attn_load(PROJ, attn_decode(u0), tid, w, g, c16, kq[0], vq[0], qn[0]);
    if (u0 + F.G < 3 * 2048) attn_load(PROJ, attn_decode(u0 + F.G), tid, w, g, c16, kq[1], vq[1], qn[1]);
    for (int ub = u0; ub < 3 * 2048; ub += 2 * F.G)
#pragma unroll
    for (int kk2 = 0; kk2 < 2; ++kk2) {
        const int u = ub + kk2 * F.G; if (u >= 3 * 2048) break;
        const AttnUnit a = attn_decode(u); const int p = a.p, dil = a.dil, n = a.n, cls = a.cls, b = a.b, h = a.h;
        __syncthreads();
        { const int row = tid >> 1, half = tid & 1;
#pragma unroll
          for (int i = 0; i < 4; ++i) { *(LAS v4u*)(Ks + row * AT_PITCH + 64 * half + 16 * i) = kq[kk2][i]; *(LAS v4u*)(Vs + row * AT_PITCH + 64 * half + 16 * i) = vq[kk2][i]; } }
        pg8::bf16x8 qf[2]; qf[0] = qn[kk2][0]; qf[1] = qn[kk2][1];
        const int qidx = 128 * n + 16 * w + c16; const size_t mq = (size_t)b * SEQ + (size_t)qidx * dil + cls;
        __syncthreads();
        if (u + 2 * F.G < 3 * 2048) attn_load(PROJ, attn_decode(u + 2 * F.G), tid, w, g, c16, kq[kk2], vq[kk2], qn[kk2]);
        pg8::f32x4 s[9];
#pragma unroll
        for (int jt = 0; jt < 9; ++jt) {
            const LAS unsigned char* kp = Ks + (16 * w + 16 * jt + c16) * AT_PITCH + 16 * g;
            const pg8::bf16x8 k0 = *(const LAS pg8::bf16x8*)kp, k1 = *(const LAS pg8::bf16x8*)(kp + 64);
            pg8::f32x4 a = (pg8::f32x4){0.f, 0.f, 0.f, 0.f};
            a = __builtin_amdgcn_mfma_f32_16x16x32_bf16(k0, qf[0], a, 0, 0, 0);
            a = __builtin_amdgcn_mfma_f32_16x16x32_bf16(k1, qf[1], a, 0, 0, 0);
            s[jt] = a;
        }
        const float NEG = -INFINITY; float mx = NEG;
#pragma unroll
        for (int jt = 0; jt < 9; ++jt)
#pragma unroll
            for (int e = 0; e < 4; ++e) { const int kw = 16 * w + 16 * jt + 4 * g + e; const int qw = 128 + 16 * w + c16;
                bool ok = true; if (jt == 0) ok = kw >= qw - 128; if (jt == 8) ok = kw <= qw; if (n == 0) ok = ok && (kw >= 128);
                if (!ok) s[jt][e] = NEG; mx = fmaxf(mx, s[jt][e]); }
        mx = fmaxf(mx, __shfl_xor(mx, 16)); mx = fmaxf(mx, __shfl_xor(mx, 32));
        float lsum = 0.f;
#pragma unroll
        for (int jt = 0; jt < 9; ++jt)
#pragma unroll
            for (int e = 0; e < 4; ++e) { const float pe = __builtin_amdgcn_exp2f((s[jt][e] - mx) * 1.4426950408889634f); s[jt][e] = pe; lsum += pe; }
        lsum += __shfl_xor(lsum, 16); lsum += __shfl_xor(lsum, 32);
        pg8::f32x4 o[4];
#pragma unroll
        for (int dt = 0; dt < 4; ++dt) o[dt] = (pg8::f32x4){0.f, 0.f, 0.f, 0.f};
#pragma unroll
        for (int jp = 0; jp < 5; ++jp) {
            v4u pw; pw.x = cvtpk(s[2 * jp][0], s[2 * jp][1]); pw.y = cvtpk(s[2 * jp][2], s[2 * jp][3]);
            if (jp < 4) { pw.z = cvtpk(s[2 * jp + 1][0], s[2 * jp + 1][1]); pw.w = cvtpk(s[2 * jp + 1][2], s[2 * jp + 1][3]); } else { pw.z = 0u; pw.w = 0u; }
            const pg8::bf16x8 pf = __builtin_bit_cast(pg8::bf16x8, pw);
            typedef short s4v __attribute__((ext_vector_type(4)));
            const LAS unsigned char* va = Vs + (16 * w + 32 * jp + 4 * g + (c16 >> 2)) * AT_PITCH + 8 * (c16 & 3);
#pragma unroll
            for (int dt = 0; dt < 4; ++dt) {
                const s4v lo = __builtin_amdgcn_ds_read_tr16_b64_v4i16((LAS s4v*)(va + 32 * dt));
                const s4v hi = __builtin_amdgcn_ds_read_tr16_b64_v4i16((LAS s4v*)(va + 32 * dt + 16 * AT_PITCH));
                o[dt] = __builtin_amdgcn_mfma_f32_16x16x32_bf16(__builtin_shufflevector(lo, hi, 0, 1, 2, 3, 4, 5, 6, 7), pf, o[dt], 0, 0, 0);
            }
        }
        const float il = 1.0f / lsum;
        bf16* op = (bf16*)(PB + mq * PROW + OP_OFF + 1024 * p) + 64 * h + 4 * g;
#pragma unroll
        for (int dt = 0; dt < 4; ++dt) { u32x2 ow; ow.x = cvtpk(o[dt][0] * il, o[dt][1] * il); ow.y = cvtpk(o[dt][2] * il, o[dt][3] * il); __builtin_nontemporal_store(ow, (u32x2*)(op + 16 * dt)); }
        if (g == 0) *(float*)(PB + mq * PROW + LSE_OFF + 4 * (8 * p + h)) = mx + __logf(lsum);
    }
}

constexpr int AR_KS = 0, AR_VS = 3 * 128 * AT_PITCH, AR_VPAD = 6 * 128 * AT_PITCH, AR_SLOT = 128 * AT_PITCH;
__device__ __forceinline__ AttnUnit attn_chain_unit(int c, int i) {
    AttnUnit a; const int seg = i >> 3, ii = i & 7;
    if (seg == 0) { a.p = 0; a.dil = 1; const int bh = c >> 2; a.b = bh >> 3; a.h = bh & 7; a.cls = 0; a.n = 8 * (c & 3) + ii; }
    else if (seg == 1) { a.p = 1; a.dil = 4; const int bh = c >> 2; a.b = bh >> 3; a.h = bh & 7; a.cls = c & 3; a.n = ii; }
    else { a.p = 2; a.dil = 16; const int ch = 4 * c + (ii >> 1); const int bh = ch >> 4; a.b = bh >> 3; a.h = bh & 7; a.cls = ch & 15; a.n = ii & 1; }
    return a;
}
__device__ __forceinline__ void attn_ring_load(const bf16* PROJ, const AttnUnit& a, int nblk, int tid, v4u (&kst)[2], v4u (&vst)[2]) {
    const int row = tid >> 2, part = tid & 3; const int idx = 128 * nblk + row;
    const bf16* kp = PROJ + ((size_t)a.b * SEQ + (size_t)idx * a.dil + a.cls) * NPROJ + 512 + 64 * a.h + 16 * part;
    kst[0] = *(const v4u*)kp; kst[1] = *(const v4u*)(kp + 8); vst[0] = *(const v4u*)(kp + 512); vst[1] = *(const v4u*)(kp + 520);
}
__device__ __forceinline__ void attn_ring_fill(LAS unsigned char* lds, int slot, int tid, const v4u (&kst)[2], const v4u (&vst)[2]) {
    const int row = tid >> 2, part = tid & 3; LAS unsigned char* kd = lds + AR_KS + slot * AR_SLOT + row * AT_PITCH + 32 * part; LAS unsigned char* vd = lds + AR_VS + slot * AR_SLOT + row * AT_PITCH + 32 * part;
    *(LAS v4u*)kd = kst[0]; *(LAS v4u*)(kd + 16) = kst[1]; *(LAS v4u*)vd = vst[0]; *(LAS v4u*)(vd + 16) = vst[1];
}
__device__ __forceinline__ void attn_ring_q(const bf16* PROJ, const AttnUnit& a, int w, int g, int c16, pg8::bf16x8 (&qf)[2]) {
    const int qidx = 128 * a.n + 16 * w + c16; const size_t mq = (size_t)a.b * SEQ + (size_t)qidx * a.dil + a.cls;
    const bf16* qp = PROJ + mq * NPROJ + 64 * a.h + 8 * g; qf[0] = *(const pg8::bf16x8*)qp; qf[1] = *(const pg8::bf16x8*)(qp + 32);
}
__device__ __forceinline__ void attn_phase_ring(Frame& F) {
    const bf16* PROJ = (const bf16*)(F.ws + WS_PROJ); unsigned char* PB = F.ws + WS_PROJ;
    const int lane = F.lane, w = F.wave, g = lane >> 4, c16 = lane & 15, tid = F.tid, c = F.vcu;
    constexpr int NU = 24;
    __syncthreads();
    for (int i = tid; i < 16 * AT_PITCH / 4; i += 512) ((LAS unsigned*)(F.lds + AR_VPAD))[i] = 0u;
    for (int i = tid; i < AR_SLOT / 4; i += 512) ((LAS unsigned*)(F.lds + AR_VS + 2 * AR_SLOT))[i] = 0u;
    v4u kst[2], vst[2]; pg8::bf16x8 qs[2][2];
    { const AttnUnit a0 = attn_chain_unit(c, 0);
      __syncthreads();
      if (a0.n > 0) { attn_ring_load(PROJ, a0, a0.n - 1, tid, kst, vst); attn_ring_fill(F.lds, 2, tid, kst, vst); }
      attn_ring_load(PROJ, a0, a0.n, tid, kst, vst); attn_ring_fill(F.lds, 0, tid, kst, vst);
      attn_ring_q(PROJ, a0, w, g, c16, qs[0]);
      const AttnUnit a1 = attn_chain_unit(c, 1);
      attn_ring_load(PROJ, a1, a1.n, tid, kst, vst); attn_ring_q(PROJ, a1, w, g, c16, qs[1]); }
    for (int ib = 0; ib < NU; ib += 2)
#pragma unroll
    for (int kk2 = 0; kk2 < 2; ++kk2) {
        const int i = ib + kk2;
        const AttnUnit a = attn_chain_unit(c, i); const int p = a.p, dil = a.dil, n = a.n, cls = a.cls, b = a.b, h = a.h;
        const int s_cur = i % 3, s_prev = (i + 2) % 3, s_next = (i + 1) % 3;
        const LAS unsigned char* Kc = F.lds + AR_KS + s_cur * AR_SLOT; const LAS unsigned char* Kp = F.lds + AR_KS + s_prev * AR_SLOT;
        const LAS unsigned char* Vc = F.lds + AR_VS + s_cur * AR_SLOT; const LAS unsigned char* Vp = F.lds + AR_VS + s_prev * AR_SLOT;
        const int qidx = 128 * n + 16 * w + c16; const size_t mq = (size_t)b * SEQ + (size_t)qidx * dil + cls;
        __syncthreads();
        pg8::f32x4 s[9];
#pragma unroll
        for (int jt = 0; jt < 9; ++jt) {
            const int gi = w + jt;
            const LAS unsigned char* kp = (gi >= 8 ? Kc : Kp) + (16 * (gi & 7) + c16) * AT_PITCH + 16 * g;
            const pg8::bf16x8 k0 = *(const LAS pg8::bf16x8*)kp, k1 = *(const LAS pg8::bf16x8*)(kp + 64);
            pg8::f32x4 acc = (pg8::f32x4){0.f, 0.f, 0.f, 0.f};
            acc = __builtin_amdgcn_mfma_f32_16x16x32_bf16(k0, qs[kk2][0], acc, 0, 0, 0);
            acc = __builtin_amdgcn_mfma_f32_16x16x32_bf16(k1, qs[kk2][1], acc, 0, 0, 0);
            s[jt] = acc;
        }
        const float NEG = -INFINITY; float mx = NEG;
#pragma unroll
        for (int jt = 0; jt < 9; ++jt)
#pragma unroll
            for (int e = 0; e < 4; ++e) { const int kw = 16 * w + 16 * jt + 4 * g + e; const int qw = 128 + 16 * w + c16;
                bool ok = true; if (jt == 0) ok = kw >= qw - 128; if (jt == 8) ok = kw <= qw; if (n == 0) ok = ok && (kw >= 128);
                if (!ok) s[jt][e] = NEG; mx = fmaxf(mx, s[jt][e]); }
        mx = fmaxf(mx, __shfl_xor(mx, 16)); mx = fmaxf(mx, __shfl_xor(mx, 32));
        float lsum = 0.f;
#pragma unroll
        for (int jt = 0; jt < 9; ++jt)
#pragma unroll
            for (int e = 0; e < 4; ++e) { const float pe = __builtin_amdgcn_exp2f((s[jt][e] - mx) * 1.4426950408889634f); s[jt][e] = pe; lsum += pe; }
        lsum += __shfl_xor(lsum, 16); lsum += __shfl_xor(lsum, 32);
        { attn_ring_fill(F.lds, s_next, tid, kst, vst);
          const int i2 = (i + 2 < NU) ? i + 2 : NU - 1; const AttnUnit a2 = attn_chain_unit(c, i2);
          attn_ring_load(PROJ, a2, a2.n, tid, kst, vst); attn_ring_q(PROJ, a2, w, g, c16, qs[kk2]); }
        pg8::f32x4 o[4];
#pragma unroll
        for (int dt = 0; dt < 4; ++dt) o[dt] = (pg8::f32x4){0.f, 0.f, 0.f, 0.f};
#pragma unroll
        for (int jp = 0; jp < 5; ++jp) {
            v4u pw; pw.x = cvtpk(s[2 * jp][0], s[2 * jp][1]); pw.y = cvtpk(s[2 * jp][2], s[2 * jp][3]);
            if (jp < 4) { pw.z = cvtpk(s[2 * jp + 1][0], s[2 * jp + 1][1]); pw.w = cvtpk(s[2 * jp + 1][2], s[2 * jp + 1][3]); } else { pw.z = 0u; pw.w = 0u; }
            const pg8::bf16x8 pf = __builtin_bit_cast(pg8::bf16x8, pw);
            typedef short s4v __attribute__((ext_vector_type(4)));
            const int gl = w + 2 * jp, gh = gl + 1;
            const int lrow = 4 * g + (c16 >> 2), lcol = 8 * (c16 & 3);
            const LAS unsigned char* val = (gl >= 8 ? Vc : Vp) + (16 * (gl & 7) + lrow) * AT_PITCH + lcol;
            const LAS unsigned char* vah = (gh >= 16 ? (const LAS unsigned char*)(F.lds + AR_VPAD) : (gh >= 8 ? Vc : Vp) + 16 * (gh & 7) * AT_PITCH) + lrow * AT_PITCH + lcol;
#pragma unroll
            for (int dt = 0; dt < 4; ++dt) {
                const s4v lo = __builtin_amdgcn_ds_read_tr16_b64_v4i16((LAS s4v*)(val + 32 * dt));
                const s4v hi = __builtin_amdgcn_ds_read_tr16_b64_v4i16((LAS s4v*)(vah + 32 * dt));
                o[dt] = __builtin_amdgcn_mfma_f32_16x16x32_bf16(__builtin_shufflevector(lo, hi, 0, 1, 2, 3, 4, 5, 6, 7), pf, o[dt], 0, 0, 0);
            }
        }
        const float il = 1.0f / lsum;
        bf16* op = (bf16*)(PB + mq * PROW + OP_OFF + 1024 * p) + 64 * h + 4 * g;
#pragma unroll
        for (int dt = 0; dt < 4; ++dt) { u32x2 ow; ow.x = cvtpk(o[dt][0] * il, o[dt][1] * il); ow.y = cvtpk(o[dt][2] * il, o[dt][3] * il); *(u32x2*)(op + 16 * dt) = ow; }
        if (g == 0) *(float*)(PB + mq * PROW + LSE_OFF + 4 * (8 * p + h)) = mx + __logf(lsum);
    }
}

__device__ __forceinline__ void post_phase(Frame& F, int l) {
    const bf16* YS = (const bf16*)(F.ws + WS_YS); const bf16* BON = (const bf16*)(F.ws + WS_BONUS); const bf16* GB = (const bf16*)(F.ws + WS_G);
    const unsigned char* PB = F.ws + WS_PROJ; bf16* MIX = (bf16*)(F.ws + WS_MIX);
    const int lane = F.lane, gw = F.vcu * NWAVES + F.wave, NGW = F.G * NWAVES;
    const int h = lane >> 3, c8 = 8 * (lane & 7);
    f32x4 lg0 = *(const f32x4*)(inp(15) + (size_t)l * HW + 8 * lane), lg1 = *(const f32x4*)(inp(15) + (size_t)l * HW + 8 * lane + 4);
    f32x4 lb0 = *(const f32x4*)(inp(16) + (size_t)l * HW + 8 * lane), lb1 = *(const f32x4*)(inp(16) + (size_t)l * HW + 8 * lane + 4);
    for (int m = gw; m < M; m += NGW) {
        float o8[8];
        { const float* lp = (const float*)(PB + (size_t)m * PROW + LSE_OFF); const float l0 = lp[h], l1 = lp[8 + h], l2 = lp[16 + h];
          const float mx = fmaxf(l0, fmaxf(l1, l2)); float w0 = fast_exp(l0 - mx), w1 = fast_exp(l1 - mx), w2 = fast_exp(l2 - mx); const float inv = 1.0f / (w0 + w1 + w2); w0 *= inv; w1 *= inv; w2 *= inv;
          const bf16* opp = (const bf16*)(PB + (size_t)m * PROW + OP_OFF) + 8 * lane; const v4u a0 = *(const v4u*)(opp), a1 = *(const v4u*)(opp + 512), a2 = *(const v4u*)(opp + 1024);
          const unsigned* p0 = (const unsigned*)&a0; const unsigned* p1 = (const unsigned*)&a1; const unsigned* p2 = (const unsigned*)&a2;
#pragma unroll
          for (int i = 0; i < 4; ++i) { o8[2 * i] = w0 * bflo(p0[i]) + w1 * bflo(p1[i]) + w2 * bflo(p2[i]); o8[2 * i + 1] = w0 * bfhi(p0[i]) + w1 * bfhi(p1[i]) + w2 * bfhi(p2[i]); } }
        v4u oa; oa.x = cvtpk(o8[0], o8[1]); oa.y = cvtpk(o8[2], o8[3]); oa.z = cvtpk(o8[4], o8[5]); oa.w = cvtpk(o8[6], o8[7]);
        __builtin_nontemporal_store(oa, (v4u*)(MIX + (size_t)m * D + 8 * lane));
        const v4u yr = *(const v4u*)(YS + (size_t)m * HW + 8 * lane);
        const f32x4 y0 = (f32x4){bflo(yr.x), bfhi(yr.x), bflo(yr.y), bfhi(yr.y)}, y1 = (f32x4){bflo(yr.z), bfhi(yr.z), bflo(yr.w), bfhi(yr.w)};
        const float bsc = ((const float*)BON)[(size_t)m * 8 + h];
        const unsigned char* vrow = (const unsigned char*)(F.ws + WS_SCANIN) + ((size_t)((m >> 12) * 8 + h) * SEQ + (m & (SEQ - 1))) * SC_ROW + 640 + 32 * ((lane & 7) & 3) + 8 * ((lane & 7) >> 2);
        const u32x2 vq0 = *(const u32x2*)vrow, vq1 = *(const u32x2*)(vrow + 16);
        const v4u gq = *(const v4u*)(GB + (size_t)m * HW + 8 * lane);
        float s = (y0.x + y0.y) + (y0.z + y0.w) + (y1.x + y1.y) + (y1.z + y1.w); s = red8(s);
        const float mean = s * (1.0f / 64.0f);
        const f32x4 d0 = y0 - mean, d1 = y1 - mean;
        float qv = (d0.x * d0.x + d0.y * d0.y) + (d0.z * d0.z + d0.w * d0.w) + (d1.x * d1.x + d1.y * d1.y) + (d1.z * d1.z + d1.w * d1.w); qv = red8(qv);
        const float rstd = 1.0f / sqrtf(qv * (1.0f / 64.0f) + GN_EPS);
        const f32x4 bn0 = (f32x4){bflo(vq0.x), bfhi(vq0.x), bflo(vq0.y), bfhi(vq0.y)} * bsc, bn1 = (f32x4){bflo(vq1.x), bfhi(vq1.x), bflo(vq1.y), bfhi(vq1.y)} * bsc;
        const f32x4 yn0 = d0 * rstd * lg0 + lb0 + bn0, yn1 = d1 * rstd * lg1 + lb1 + bn1;
        v4u ob; ob.x = cvtpk(yn0.x * bflo(gq.x), yn0.y * bfhi(gq.x)); ob.y = cvtpk(yn0.z * bflo(gq.y), yn0.w * bfhi(gq.y)); ob.z = cvtpk(yn1.x * bflo(gq.z), yn1.y * bfhi(gq.z)); ob.w = cvtpk(yn1.z * bflo(gq.w), yn1.w * bfhi(gq.w));
        __builtin_nontemporal_store(ob, (v4u*)(MIX + (size_t)m * D + HW + 8 * lane));
    }
}

template <int MODE, bool ROUTE, bool LAST>
__device__ __forceinline__ void ln_phase(Frame& F, const bf16* Yb, const float* gam, const float* bet, const float* router, unsigned* cnt, bf16* XO = nullptr, const unsigned* tcnt = nullptr) {
    bf16* XB = (bf16*)(F.ws + WS_XB); if (XO == nullptr) XO = XB;
    int tslot0 = 0x7fffffff, tS = 1;
    if (MODE == 1 && tcnt != nullptr) { const TailPlan p = tail_plan(tcnt, D / 256, F.G, true); tS = p.S; if (tS > 1) tslot0 = p.pm0 * 256; }
    const int lane = F.lane, gw = F.vcu * NWAVES + F.wave, NGW = F.G * NWAVES;
    f32x4 gv[4], bv[4];
#pragma unroll
    for (int j = 0; j < 4; ++j) { gv[j] = *(const f32x4*)(gam + 4 * lane + 256 * j); bv[j] = *(const f32x4*)(bet + 4 * lane + 256 * j); }
    f32x4 rw[ROUTE ? 16 : 1][2];
    LAS unsigned* lcnt = (LAS unsigned*)F.lds;
    int my_e0 = 0, my_e1 = 0, my_p0 = 0, my_p1 = 0, my_m = -1; float my_g0 = 0.f, my_g1 = 0.f; int it_ = 0;
    int cwv[8] = {0, 0, 0, 0, 0, 0, 0, 0};
    if (ROUTE) { __syncthreads(); }
    if (ROUTE) {
#pragma unroll
        for (int j = 0; j < 4; ++j)
#pragma unroll
            for (int i = 0; i < 4; ++i) { const float* rp = router + (size_t)(4 * lane + 256 * j + i) * 8; rw[4 * j + i][0] = *(const f32x4*)rp; rw[4 * j + i][1] = *(const f32x4*)(rp + 4); }
    }
#define LN_LOAD(mm, XA, YA, YB2) do { _Pragma("unroll") for (int j = 0; j < 4; ++j) { XA[j] = *(const u32x2*)(XB + (size_t)(mm) * D + 4 * lane + 256 * j); \
        if (MODE == 0) YA[j] = *(const u32x2*)(Yb + (size_t)(mm) * D + 4 * lane + 256 * j); \
        else { YA[j] = *(const u32x2*)(Yb + (size_t)(2 * (mm)) * D + 4 * lane + 256 * j); YB2[j] = *(const u32x2*)(Yb + (size_t)(2 * (mm) + 1) * D + 4 * lane + 256 * j); } } } while (0)
    u32x2 nxa[4], nya[4], nyb[4];
    LN_LOAD(gw, nxa, nya, nyb);
    for (int m = gw; m < M; m += NGW) {
        f32x4 z[4]; float s = 0.f;
        u32x2 cxa[4], cya[4], cyb[4];
        {
#pragma unroll
            for (int j = 0; j < 4; ++j) { cxa[j] = nxa[j]; cya[j] = nya[j]; if (MODE != 0) cyb[j] = nyb[j]; }
            const int mn = (m + NGW < M) ? m + NGW : m;
            LN_LOAD(mn, nxa, nya, nyb);
        }
        f32x4 tadd[4];
        if (MODE == 1 && tS > 1) {
#pragma unroll
            for (int j = 0; j < 4; ++j) tadd[j] = (f32x4){0.f, 0.f, 0.f, 0.f};
            const int* chp = (const int*)(F.ws + WS_CHOICE) + (size_t)m * 8;
            const int sl[2] = {__builtin_amdgcn_readfirstlane(chp[6]), __builtin_amdgcn_readfirstlane(chp[7])};
#pragma unroll
            for (int jj = 0; jj < 2; ++jj) if (sl[jj] >= tslot0) {
                for (int qq = 1; qq < tS; ++qq) { const float* pr = (const float*)(F.ws + WS_PT) + ((size_t)(qq - 1) * PT_TILES * 256 + (sl[jj] - tslot0)) * D + 4 * lane;
#pragma unroll
                    for (int j = 0; j < 4; ++j) tadd[j] = tadd[j] + *(const f32x4*)(pr + 256 * j); } }
        }
#pragma unroll
        for (int j = 0; j < 4; ++j) {
            const u32x2 xa = cxa[j];
            f32x4 f;
            if (MODE == 0) { const u32x2 ya = cya[j]; f = (f32x4){bflo(ya.x), bfhi(ya.x), bflo(ya.y), bfhi(ya.y)}; }
            else { const u32x2 ya = cya[j], yb = cyb[j];
                   f = (f32x4){bflo(ya.x) + bflo(yb.x), bfhi(ya.x) + bfhi(yb.x), bflo(ya.y) + bflo(yb.y), bfhi(ya.y) + bfhi(yb.y)};
                   if (tS > 1) f = f + tadd[j]; }
            z[j] = (f32x4){bflo(xa.x), bfhi(xa.x), bflo(xa.y), bfhi(xa.y)} * DN_ALPHA + f;
            s += (z[j].x + z[j].y) + (z[j].z + z[j].w);
        }
        const float mean = wave_sum(s) * (1.0f / D); float s2 = 0.f;
#pragma unroll
        for (int j = 0; j < 4; ++j) { z[j] = z[j] - mean; s2 += (z[j].x * z[j].x + z[j].y * z[j].y) + (z[j].z * z[j].z + z[j].w * z[j].w); }
        const float rstd = 1.0f / sqrtf(wave_sum(s2) * (1.0f / D) + LN_EPS);
#pragma unroll
        for (int j = 0; j < 4; ++j) z[j] = z[j] * rstd * gv[j] + bv[j];
        if (LAST) {
#pragma unroll
            for (int j = 0; j < 4; ++j) *(GAS f32x4*)(F.out + (size_t)m * D + 4 * lane + 256 * j) = z[j];
        } else {
#pragma unroll
            for (int j = 0; j < 4; ++j) { u32x2 o; o.x = cvtpk(z[j].x, z[j].y); o.y = cvtpk(z[j].z, z[j].w); *(u32x2*)(XO + (size_t)m * D + 4 * lane + 256 * j) = o; }
        }
        if (ROUTE) {
            float lg[8];
#pragma unroll
            for (int e = 0; e < 8; ++e) lg[e] = 0.f;
#pragma unroll
            for (int j = 0; j < 4; ++j)
#pragma unroll
                for (int i = 0; i < 4; ++i) { const float xv = z[j][i]; const f32x4 ra = rw[ROUTE ? 4 * j + i : 0][0], rb = rw[ROUTE ? 4 * j + i : 0][1];
                    lg[0] += xv * ra.x; lg[1] += xv * ra.y; lg[2] += xv * ra.z; lg[3] += xv * ra.w; lg[4] += xv * rb.x; lg[5] += xv * rb.y; lg[6] += xv * rb.z; lg[7] += xv * rb.w; }
#pragma unroll
            for (int e = 0; e < 8; ++e) (void)e;
            {
              const bool b0 = (lane & 1) != 0, b1 = (lane & 2) != 0, b2 = (lane & 4) != 0;
              float v4[4], v2[2];
#pragma unroll
              for (int i = 0; i < 4; ++i) { const float keep = b0 ? lg[2 * i + 1] : lg[2 * i], send = b0 ? lg[2 * i] : lg[2 * i + 1]; v4[i] = keep + dppf<0xB1>(send); }
#pragma unroll
              for (int i = 0; i < 2; ++i) { const float keep = b1 ? v4[2 * i + 1] : v4[2 * i], send = b1 ? v4[2 * i] : v4[2 * i + 1]; v2[i] = keep + dppf<0x4E>(send); }
              const float keep = b2 ? v2[1] : v2[0], send = b2 ? v2[0] : v2[1];
              float v1 = keep + __builtin_bit_cast(float, __builtin_amdgcn_ds_swizzle(__builtin_bit_cast(int, send), 0x101F));
              v1 += __builtin_bit_cast(float, __builtin_amdgcn_ds_swizzle(__builtin_bit_cast(int, v1), 0x201F));
              v1 += __builtin_bit_cast(float, __builtin_amdgcn_ds_swizzle(__builtin_bit_cast(int, v1), 0x401F));
              v1 += __shfl_xor(v1, 32);
#pragma unroll
              for (int e = 0; e < 8; ++e) lg[e] = __builtin_bit_cast(float, __builtin_amdgcn_readlane(__builtin_bit_cast(int, v1), e));
            }
            int e0 = 0; float v0 = lg[0];
#pragma unroll
            for (int e = 1; e < 8; ++e) if (lg[e] > v0) { v0 = lg[e]; e0 = e; }
            int e1 = -1; float v1 = -INFINITY;
#pragma unroll
            for (int e = 0; e < 8; ++e) if (e != e0 && lg[e] > v1) { v1 = lg[e]; e1 = e; }
            const float g1 = 1.0f / (1.0f + __expf(v0 - v1)), g0 = 1.0f - g1;
            int p0 = 0, p1 = 0;
#pragma unroll
            for (int e = 0; e < 8; ++e) { if (e == e0) { p0 = cwv[e]; cwv[e] += 1; } if (e == e1) { p1 = cwv[e]; cwv[e] += 1; } }
            if (lane == it_) { my_e0 = e0; my_e1 = e1; my_p0 = (int)p0; my_p1 = (int)p1; my_g0 = g0; my_g1 = g1; my_m = m; }
            ++it_;
        }
    }
    if (ROUTE) {
        int mine = 0;
#pragma unroll
        for (int e = 0; e < 8; ++e) if (lane == e) mine = cwv[e];
        if (lane < 8) lcnt[F.wave * 8 + lane] = (unsigned)mine;
        __syncthreads();
        if (F.tid < 64) { const int w2 = F.tid >> 3, e = F.tid & 7; unsigned pre = 0u; for (int w3 = 0; w3 < w2; ++w3) pre += lcnt[w3 * 8 + e]; lcnt[64 + F.tid] = pre;
            if (w2 == 7) { const unsigned tot = pre + lcnt[56 + e]; ((int*)(F.ws + WS_CNTB))[F.vcu * 8 + e] = (int)tot; atomicAdd(cnt + e, tot); } }
        __syncthreads();
        if (my_m >= 0) { int* ch = (int*)(F.ws + WS_CHOICE) + (size_t)my_m * 8;
            ch[0] = my_e0; ch[1] = my_e1; ch[2] = my_p0 + (int)lcnt[64 + F.wave * 8 + my_e0]; ch[3] = my_p1 + (int)lcnt[64 + F.wave * 8 + my_e1]; ((float*)ch)[4] = my_g0; ((float*)ch)[5] = my_g1; }
    }
}

__device__ __forceinline__ void moe_build_phase(Frame& F, const unsigned* cnt) {
    const bf16* XB = (const bf16*)(F.ws + WS_XB); bf16* XS = (bf16*)(F.ws + WS_XS); int* RD = (int*)(F.ws + WS_ROWDST); float* RG = (float*)(F.ws + WS_ROWGATE);
    const int lane = F.lane, gw = F.vcu * NWAVES + F.wave, NGW = F.G * NWAVES;
    int off[9]; off[0] = 0;
#pragma unroll
    for (int e = 0; e < 8; ++e) off[e + 1] = off[e] + (int)(((cnt[e] + 255u) >> 8) << 8);
    LAS int* bb = (LAS int*)F.lds;
    __syncthreads(); if (F.tid < 8) bb[F.tid] = 0; __syncthreads();
    if (F.tid < F.vcu) { const int* cb = (const int*)(F.ws + WS_CNTB) + (size_t)F.tid * 8;
#pragma unroll
        for (int e = 0; e < 8; ++e) __hip_atomic_fetch_add(bb + e, cb[e], __ATOMIC_RELAXED, __HIP_MEMORY_SCOPE_WORKGROUP); }
    __syncthreads();
#pragma unroll
    for (int e = 0; e < 8; ++e) off[e] += bb[e];
    int* RS = (int*)(F.ws + WS_ROWSRC);
    for (int m = gw + lane * NGW; m < M; m += 64 * NGW) {
        const int* ch = (const int*)(F.ws + WS_CHOICE) + (size_t)m * 8;
        const v4u c4 = *(const v4u*)ch; const u32x2 g2 = *(const u32x2*)(ch + 4);
        const int e0 = (int)c4.x, e1 = (int)c4.y, p0 = (int)c4.z, p1 = (int)c4.w;
        int o0 = 0, o1 = 0;
#pragma unroll
        for (int e = 0; e < 8; ++e) { if (e == e0) o0 = off[e]; if (e == e1) o1 = off[e]; }
        const int s0 = o0 + p0, s1 = o1 + p1;
        RS[s0] = m; RS[s1] = m; RD[s0] = 2 * m; RD[s1] = 2 * m + 1; ((unsigned*)RG)[s0] = g2.x; ((unsigned*)RG)[s1] = g2.y;
        u32x2 fin; fin.x = (unsigned)s0; fin.y = (unsigned)s1; *(u32x2*)((int*)(F.ws + WS_CHOICE) + (size_t)m * 8 + 6) = fin;
    }
#pragma unroll
    for (int e = 0; e < 8; ++e) off[e] -= bb[e];
#pragma unroll
    for (int e = 0; e < 8; ++e) {
        const int lo = off[e] + (int)cnt[e], hi = off[e + 1];
        for (int s = lo + gw * 64 + lane; s < hi; s += NGW * 64) { RS[s] = -1; RD[s] = -1; RG[s] = 0.f; }
    }
}

__global__ void __launch_bounds__(NWAVES * 64, 2) fwd(Args args) {
    extern __shared__ __attribute__((aligned(16))) unsigned char lds_raw[];
    Frame F0;
    F0.lds = (LAS unsigned char*)lds_raw;
    F0.tid = 0; F0.lane = 0; F0.wave = 0;
    F0.G = gridDim.x; { const int bx = blockIdx.x; F0.vcu = (F0.G % 8 == 0) ? (bx % 8) * (F0.G / 8) + bx / 8 : bx; }
    F0.ws = args.ws; F0.out = args.out;
    volatile LAS unsigned* MISC = (volatile LAS unsigned*)(F0.lds + MISC_OFF);
    gu32* ctl = (gu32*)(F0.ws + WS_CTL);
    for (int u = threadIdx.x; u < (LDS_BYTES - RING_BYTES) / 4; u += NWAVES * 64) ((LAS unsigned*)(F0.lds + RING_BYTES))[u] = 0u;
    __syncthreads();
    const int lo = args.ph_lo, hi = args.ph_hi;
    const bool multi = (hi - lo) > 1;
    XcdBarrier bar; bar.bar = (unsigned*)(ctl + CW_BAR); bar.x = 0; bar.st = nullptr;
    if (multi) bar = xcd_barrier_post((unsigned*)(ctl + CW_BAR), MISC + 8);
#ifndef PHMASK
#define PHMASK 0xfff
#endif
#define IN(k) (((PHMASK >> ((k) % PH_PER_LAYER)) & 1) && lo <= (k) && (k) < hi)
#ifndef PROBE_TIME
#define PROBE_TIME -1
#endif
    unsigned long long pt_last = 0ull, pt_acc = 0ull;
    if (PROBE_TIME >= 0) pt_last = __builtin_amdgcn_s_memrealtime();
#define PT_STAMP(k) do { if (PROBE_TIME >= 0) { const unsigned long long now_ = __builtin_amdgcn_s_memrealtime(); if (((k) % PH_PER_LAYER) == PROBE_TIME) pt_acc += now_ - pt_last; pt_last = now_; } } while (0)
#define SEAM(k) do { if (IN((k) + 1) && IN(k)) { xcd_barrier(bar); if ((PROBE_DUP >> 12) & 1) xcd_barrier(bar); PT_STAMP(k); } } while (0)

#define REP(k, ...) do { __VA_ARGS__; if ((PROBE_DUP >> (k)) & 1) { __VA_ARGS__; } } while (0)
#define PHASE_FRAME() Frame F = F0; { int t_ = threadIdx.x; asm volatile("" : "+v"(t_)); F.tid = t_; F.lane = t_ & 63; F.wave = __builtin_amdgcn_readfirstlane(t_ >> 6); }
#define LAYER_BODY(moe) do { const int P0 = l * PH_PER_LAYER; const int li = l >> 1; (void)li; \
         \
        if (l == 0 && IN(P0 + 0)) { PHASE_FRAME(); REP(0, conv_mixer_weights(F, l); conv_x(F)); SEAM(P0 + 0); } \
         \
        if (IN(P0 + 1)) { PHASE_FRAME(); \
            pg8::Gemm g{(const pg8::bf16_t*)(F.ws + WS_XB), (const pg8::bf16_t*)(F.ws + WS_WIN), M, NPROJ, D}; NaiveOrder S; S.init(M, NPROJ, F.G, (int)blockIdx.x); \
            pg8::EpiBf16<0> E{(pg8::bf16_t*)(F.ws + WS_PROJ), NPROJ, nullptr, 0, 0, 1.f}; \
            REP(1, pg8::gemm_phase<pg8::EpiBf16<0>, NaiveOrder, true, true>(F.lds, g, S, E)); \
            SEAM(P0 + 1); \
        } \
         \
        if (IN(P0 + 2)) { PHASE_FRAME(); REP(2, if (l == 0) prep_phase<false>(F, l); else prep_phase<true>(F, l)); SEAM(P0 + 2); } \
         \
        if (IN(P0 + 3)) { PHASE_FRAME(); REP(3, scan_phase(F, l)); if (!IN(P0 + 4)) SEAM(P0 + 3); } \
        if (IN(P0 + 4)) { PHASE_FRAME(); __syncthreads(); REP(4, if (F.G == 256) attn_phase_ring(F); else attn_phase(F)); SEAM(P0 + 4); } \
         \
        if (IN(P0 + 5)) { PHASE_FRAME(); REP(5, post_phase(F, l)); SEAM(P0 + 5); } \
         \
        if (IN(P0 + 6)) { PHASE_FRAME(); \
            pg8::Gemm g{(const pg8::bf16_t*)(F.ws + WS_MIX), (const pg8::bf16_t*)(F.ws + ((l & 1) ? WS_WOUT2 : WS_WOUT)), M, D, D}; pg8::StaticOrder S; S.init(M, D, F.G, (int)blockIdx.x); \
            pg8::EpiBf16<0> E{(pg8::bf16_t*)(F.ws + WS_Y), D, nullptr, 0, 0, 1.f}; \
            REP(6, pg8::gemm_phase<pg8::EpiBf16<0>, pg8::StaticOrder, true, true>(F.lds, g, S, E)); \
            if (DBG_RECONV == 1 || (DBG_RECONV == 2 && moe) || (DBG_RECONV == 3 && !moe)) { __syncthreads(); conv_ffn_weights(F, l); } \
            SEAM(P0 + 6); \
        } \
         \
        if (IN(P0 + 7)) { PHASE_FRAME(); unsigned* cnt = (unsigned*)(F.ws + WS_CTL) + CW_MOE + 64 * li; \
            const float* gam = inp(18) + (size_t)l * D; const float* bet = inp(19) + (size_t)l * D; \
            if ((PROBE_DUP >> 11) & 1) ln_phase<0, false, false>(F, (const bf16*)(F.ws + WS_Y), gam, bet, nullptr, nullptr, (bf16*)(F.ws + WS_BIG)); \
            if (moe) ln_phase<0, true, false>(F, (const bf16*)(F.ws + WS_Y), gam, bet, inp(25) + (size_t)li * D * 8, cnt); \
            else ln_phase<0, false, false>(F, (const bf16*)(F.ws + WS_Y), gam, bet, nullptr, nullptr); \
            SEAM(P0 + 7); \
        } \
         \
        if (moe && IN(P0 + 8)) { PHASE_FRAME(); unsigned* cnt = (unsigned*)(F.ws + WS_CTL) + CW_MOE + 64 * li; REP(8, moe_build_phase(F, cnt)); SEAM(P0 + 8); } \
         \
        if (IN(P0 + 9)) { PHASE_FRAME(); unsigned* cnt = (unsigned*)(F.ws + WS_CTL) + CW_MOE + 64 * li; \
            if (!moe) { \
                pg8::Gemm g{(const pg8::bf16_t*)(F.ws + WS_XB), (const pg8::bf16_t*)(F.ws + WS_WF), M, 2 * DFF, D}; NaiveOrder S; S.init(M, 2 * DFF, F.G, (int)blockIdx.x); \
                EpiSwiglu E{(bf16*)(F.ws + WS_HID), DFF}; \
                REP(9, pg8::gemm_phase<EpiSwiglu, NaiveOrder, true, true>(F.lds, g, S, E)); \
            } else { \
                pg8::Gemm g{(const pg8::bf16_t*)(F.ws), (const pg8::bf16_t*)(F.ws + WS_WF), MOE_ROWS, 2 * DFE, D, (const int*)(F.ws + WS_ROWSRC), (unsigned)WS_XB, (unsigned)WS_ZROW}; GroupedOrder S; S.init(cnt, 2 * DFE / 256, F.G, (int)blockIdx.x, (unsigned)(2 * DFE * D * 2)); \
                EpiSwiglu E{(bf16*)(F.ws + WS_HID), DFE}; \
                REP(9, pg8::gemm_phase<EpiSwiglu, GroupedOrder, true, true, true>(F.lds, g, S, E)); \
            } \
            SEAM(P0 + 9); \
        } \
         \
        if (IN(P0 + 10)) { PHASE_FRAME(); unsigned* cnt = (unsigned*)(F.ws + WS_CTL) + CW_MOE + 64 * li; \
            if (!moe) { \
                pg8::Gemm g{(const pg8::bf16_t*)(F.ws + WS_HID), (const pg8::bf16_t*)(F.ws + WS_WFD), M, D, DFF}; pg8::StaticOrder S; S.init(M, D, F.G, (int)blockIdx.x); \
                pg8::EpiBf16<0> E{(pg8::bf16_t*)(F.ws + WS_Y2), D, nullptr, 0, 0, 1.f}; \
                REP(10, pg8::gemm_phase<pg8::EpiBf16<0>, pg8::StaticOrder, true, true>(F.lds, g, S, E)); \
            } else { \
                pg8::Gemm g{(const pg8::bf16_t*)(F.ws + WS_HID), (const pg8::bf16_t*)(F.ws + WS_WFD), MOE_ROWS, D, DFE}; GroupedOrder S; S.init(cnt, D / 256, F.G, (int)blockIdx.x, (unsigned)(D * DFE * 2), true, DFE); \
                EpiMoeDown E{(bf16*)(F.ws + WS_YPAIR), (const int*)(F.ws + WS_ROWDST), (const float*)(F.ws + WS_ROWGATE), (float*)(F.ws + WS_PT), tail_plan(cnt, D / 256, F.G, true).pm0 * 256}; \
                REP(10, pg8::gemm_phase<EpiMoeDown, GroupedOrder, true, true>(F.lds, g, S, E)); \
            } \
            SEAM(P0 + 10); \
        } \
         \
        if (IN(P0 + 11)) { PHASE_FRAME(); \
            const float* gam = inp(20) + (size_t)l * D; const float* bet = inp(21) + (size_t)l * D; \
            if ((PROBE_DUP >> 11) & 1) { if (moe) ln_phase<1, false, false>(F, (const bf16*)(F.ws + WS_YPAIR), gam, bet, nullptr, nullptr, (bf16*)(F.ws + WS_BIG)); else ln_phase<0, false, false>(F, (const bf16*)(F.ws + WS_Y2), gam, bet, nullptr, nullptr, (bf16*)(F.ws + WS_BIG)); } \
            if (l == DEPTH - 1) ln_phase<1, false, true>(F, (const bf16*)(F.ws + WS_YPAIR), gam, bet, nullptr, nullptr, nullptr, (const unsigned*)(F.ws + WS_CTL) + CW_MOE + 64 * li); \
            else if (moe) ln_phase<1, false, false>(F, (const bf16*)(F.ws + WS_YPAIR), gam, bet, nullptr, nullptr, nullptr, (const unsigned*)(F.ws + WS_CTL) + CW_MOE + 64 * li); \
            else ln_phase<0, false, false>(F, (const bf16*)(F.ws + WS_Y2), gam, bet, nullptr, nullptr); \
            if (l + 1 < DEPTH) { __syncthreads(); REP(0, conv_mixer_rest(F, l + 1)); } \
            if (l + 1 < DEPTH && lo <= P0 + 11 && P0 + 13 < hi) { xcd_barrier(bar); PT_STAMP(P0 + 11); } \
        } \
    } while (0)
    { constexpr int l = 0; LAYER_BODY(false); }
    { constexpr int l = 1; LAYER_BODY(true); }
    { constexpr int l = 2; LAYER_BODY(false); }
    { constexpr int l = 3; LAYER_BODY(true); }
    if (PROBE_TIME >= 0) { PT_STAMP(N_PHASES - 1); if (blockIdx.x == 0 && threadIdx.x == 0) { const unsigned long long t0_ = __builtin_amdgcn_s_memrealtime(); while (__builtin_amdgcn_s_memrealtime() - t0_ < 2ull * pt_acc) __builtin_amdgcn_s_sleep(8); } }
#undef IN
#undef SEAM
}

extern "C" void kernel_launch(void* const* d_in, const int* in_sizes, int n_in, void* d_out, int out_size, void* d_ws, size_t ws_size, hipStream_t stream) {
    static int grid = 0;
    if (grid == 0) {
        if (n_in != 29 || in_sizes[0] != M * D || out_size != M * D || ws_size < WS_END) { fprintf(stderr, "kernel_launch: unexpected shapes / workspace (%d inputs, ws %zu)\n", n_in, ws_size); grid = -1; return; }
        int dev = 0, cus = 0;
        if (hipGetDevice(&dev) != hipSuccess || hipDeviceGetAttribute(&cus, hipDeviceAttributeMultiprocessorCount, dev) != hipSuccess) { grid = -1; return; }
        if (hipFuncSetAttribute((const void*)fwd, hipFuncAttributeMaxDynamicSharedMemorySize, LDS_BYTES) != hipSuccess) { grid = -1; return; }
        grid = cus;
    }
    if (grid < 0) return;
    (void)hipMemsetAsync((char*)d_ws + WS_CTL, 0, CTL_ZERO_BYTES, stream);
    Args a{};
    for (int i = 0; i < 29; ++i) a.in[i] = (const float*)d_in[i];
    a.out = (float*)d_out; a.ws = (unsigned char*)d_ws;
#ifndef ONE_LAUNCH
#define ONE_LAUNCH 1
#endif
    if (ONE_LAUNCH) { a.ph_lo = 0; a.ph_hi = N_PHASES; hipLaunchKernelGGL(fwd, dim3(grid), dim3(NWAVES * 64), LDS_BYTES, stream, a); }
    else {
        for (int ph = 0; ph < N_PHASES; ++ph) {
            const int k = ph % PH_PER_LAYER, l = ph / PH_PER_LAYER;
            if (k == 8 && (l & 1) == 0) continue;
            a.ph_lo = ph; a.ph_hi = ph + 1;
            hipLaunchKernelGGL(fwd, dim3(grid), dim3(NWAVES * 64), LDS_BYTES, stream, a);
        }
    }
}
```
